# Optimizing an MI355X kernel written in HIP

```python
import jax, jax.numpy as jnp
from jax import lax
import numpy as np

D_MODEL = 1024
BATCH = 32
SEQ = 2048
DEPTH = 2

N_META = 16
HEAD_DIM = 64
CONV_WIDTH = D_MODEL // 4
CONV_HEADS = CONV_WIDTH // HEAD_DIM
CONV_K = 3
POOL_WIDTH = D_MODEL // 4
POOL_WINDOWS = (2, 4, 8, 16)
N_POOL_GROUPS = len(POOL_WINDOWS)
PG = POOL_WIDTH // N_POOL_GROUPS
ATTN_WIDTH = D_MODEL // 2
ATTN_HEADS = ATTN_WIDTH // HEAD_DIM
MIX_WIDTH = CONV_WIDTH + POOL_WIDTH + ATTN_WIDTH
IN_WIDTH = 3 * CONV_WIDTH + POOL_WIDTH + 3 * ATTN_WIDTH
D_FF = 4 * D_MODEL
Q_BLOCK = 128
EPS = 1e-6
SPLITS = (CONV_WIDTH, 2 * CONV_WIDTH, 3 * CONV_WIDTH,
          3 * CONV_WIDTH + POOL_WIDTH,
          3 * CONV_WIDTH + POOL_WIDTH + ATTN_WIDTH,
          3 * CONV_WIDTH + POOL_WIDTH + 2 * ATTN_WIDTH)

kernel_name = "hybrid_conv_pool_stickbreak_trunk"


def rms_norm(x, g):
    xf = x.astype(jnp.float32)
    y = xf * lax.rsqrt(jnp.mean(xf * xf, axis=-1, keepdims=True) + EPS)
    return (y * g.astype(jnp.float32)).astype(x.dtype)


def causal_dwconv(u, w):
    c = u.shape[-1]
    return lax.conv_general_dilated(
        u, w[:, None, :].astype(u.dtype), window_strides=(1,),
        padding=[(CONV_K - 1, 0)], dimension_numbers=("NWC", "WIO", "NWC"),
        feature_group_count=c)


def multiscale_pool(u, w_grp, scale):
    b, l, _ = u.shape
    ug = u.reshape(b, l, N_POOL_GROUPS, PG).astype(jnp.float32)
    cs = jnp.concatenate([jnp.zeros((b, 1, N_POOL_GROUPS, PG), jnp.float32),
                          lax.cumsum(ug, axis=1)], axis=1)
    t = jnp.arange(l)
    means = []
    for g, w in enumerate(POOL_WINDOWS):
        lo = jnp.maximum(t + 1 - w, 0)
        s = cs[:, 1:, g] - cs[:, lo, g]
        cnt = (t + 1 - lo).astype(jnp.float32)
        means.append(s / cnt[None, :, None])
    pooled = (jnp.stack(means, axis=2) - ug).astype(u.dtype)
    y = jnp.einsum("blgc,gcd->blgd", pooled, w_grp)
    return y.reshape(b, l, POOL_WIDTH) * scale


def stick_breaking_attention(q, k, v):
    l = q.shape[2]
    starts = [0] + list(range(N_META, l, Q_BLOCK))
    ends = starts[1:] + [l]
    scale = HEAD_DIM ** -0.5
    outs = []
    for start, end in zip(starts, ends):
        qb = q[:, :, start:end].astype(jnp.float32)
        kb = k[:, :, :end].astype(jnp.float32)
        z = jnp.einsum("bhqd,bhkd->bhqk", qb, kb) * scale
        mask = jnp.arange(end)[None, :] < jnp.arange(start, end)[:, None]
        log_keep = jnp.where(mask, jax.nn.log_sigmoid(-z), 0.0)
        between = lax.cumsum(log_keep, axis=3, reverse=True) - log_keep
        a = jnp.where(mask, jnp.exp(jax.nn.log_sigmoid(z) + between), 0.0)
        outs.append(jnp.einsum("bhqk,bhkd->bhqd", a, v[:, :, :end].astype(jnp.float32)))
    return jnp.concatenate(outs, axis=2).astype(v.dtype)


def setup_inputs(seed: int = 0) -> dict:
    key = jax.random.key(seed)
    ks = jax.random.split(key, 12)
    f32 = jnp.float32
    nrm = lambda k, s: jax.random.normal(k, s, f32)
    return {
        "x": nrm(ks[0], (BATCH, SEQ, D_MODEL)),
        "meta_tokens": nrm(ks[1], (N_META, D_MODEL)),
        "g_mix": 1.0 + 0.02 * nrm(ks[2], (DEPTH, D_MODEL)),
        "w_in": nrm(ks[3], (DEPTH, D_MODEL, IN_WIDTH)) * D_MODEL ** -0.5,
        "w_conv": nrm(ks[4], (DEPTH, CONV_K, CONV_WIDTH)) * CONV_K ** -0.5,
        "w_pool": nrm(ks[5], (DEPTH, N_POOL_GROUPS, PG, PG)) * PG ** -0.5,
        "pool_scale": 1.0 + 0.02 * nrm(ks[6], (DEPTH, POOL_WIDTH)),
        "w_out": nrm(ks[7], (DEPTH, MIX_WIDTH, D_MODEL)) * MIX_WIDTH ** -0.5,
        "g_mlp": 1.0 + 0.02 * nrm(ks[8], (DEPTH, D_MODEL)),
        "w_up": nrm(ks[9], (DEPTH, D_MODEL, D_FF)) * D_MODEL ** -0.5,
        "w_down": nrm(ks[10], (DEPTH, D_FF, D_MODEL)) * D_FF ** -0.5,
        "g_final": 1.0 + 0.02 * nrm(ks[11], (D_MODEL,)),
    }


def reference(x, meta_tokens, g_mix, w_in, w_conv, w_pool, pool_scale, w_out,
              g_mlp, w_up, w_down, g_final):
    b = x.shape[0]
    meta = jnp.broadcast_to(meta_tokens[None].astype(x.dtype), (b, N_META, D_MODEL))
    h = jnp.concatenate([meta, x], axis=1)
    l = h.shape[1]
    to_heads = lambda t: t.reshape(b, l, ATTN_HEADS, HEAD_DIM).transpose(0, 2, 1, 3)
    for i in range(DEPTH):
        u = rms_norm(h, g_mix[i]) @ w_in[i]
        c_b, c_c, c_x, p_in, q, k, v = jnp.split(u, SPLITS, axis=-1)
        y_conv = c_b * causal_dwconv(c_c * c_x, w_conv[i])
        y_pool = multiscale_pool(p_in, w_pool[i], pool_scale[i])
        y_attn = stick_breaking_attention(to_heads(q), to_heads(k), to_heads(v))
        y_attn = y_attn.transpose(0, 2, 1, 3).reshape(b, l, ATTN_WIDTH)
        h = h + jnp.concatenate([y_conv, y_pool, y_attn], axis=-1) @ w_out[i]
        m = rms_norm(h, g_mlp[i]) @ w_up[i]
        h = h + jnp.square(jax.nn.relu(m)) @ w_down[i]
    return rms_norm(h, g_final)[:, N_META:]
```

```cpp
#include <hip/hip_runtime.h>
#include <hip/hip_cooperative_groups.h>
#include <cstdio>
#include <cstdint>
namespace cg = cooperative_groups;

namespace pg8 {
#define PG8_LAS __attribute__((address_space(3)))
typedef unsigned short bf16_t;
typedef short bf16x8 __attribute__((ext_vector_type(8)));
typedef float f32x4 __attribute__((ext_vector_type(4)));
typedef unsigned u32x4 __attribute__((ext_vector_type(4)));
constexpr int BM = 256, BK = 64, HALF = 128, HTB = HALF * BK * 2, STAGE_BYTES = 8 * HTB;

__host__ __device__ __forceinline__ int lds_byte(int r, int c) { const int st = (r >> 4) * 2 + (c >> 5), rr = r & 15, cc = c & 31, ob = rr * 64 + cc * 2; return st * 1024 + (ob ^ (((ob >> 9) & 1) << 5)); }
__host__ __device__ __forceinline__ void stage_rc(int b, int& R, int& C) { const int st = b / 1024, sb = b % 1024, swz = sb ^ (((sb >> 9) & 1) << 5); R = (st >> 1) * 16 + swz / 64; C = (st & 1) * 32 + (swz % 64) / 2; }
__host__ __device__ __forceinline__ int perm32(int rho) { const int n = rho >> 4, i = rho & 15; return 8 * (i >> 2) + 4 * n + (i & 3); }

struct Unit { int pm, pn, idx; };
struct Gemm { const bf16_t* A; const bf16_t* Bt; int M, N, K; };

constexpr int NXCD = 8, WGM = 8;
struct StaticOrder {
    int nM, nN, nwg, G, c;
    __device__ __forceinline__ void init(int M, int N, int G_, int c_) { nM = M / BM; nN = N / BM; nwg = nM * nN; G = G_; c = c_; }
    __device__ __forceinline__ bool next(int i, Unit& u) const {
        const int L = i * G + c; if (L >= nwg) return false;
        int wgid = L; { const int q = nwg / NXCD, r = nwg % NXCD, xcd = wgid % NXCD, off = wgid / NXCD; wgid = (xcd < r ? xcd * (q + 1) : r * (q + 1) + (xcd - r) * q) + off; }
        const int nig = WGM * nN, gid = wgid / nig, fm = gid * WGM, gsz = (nM - fm) < WGM ? (nM - fm) : WGM;
        u.pm = fm + ((wgid % nig) % gsz); u.pn = (wgid % nig) / gsz; u.idx = i; return true;
    }
    __device__ __forceinline__ void a_ready(const Unit&) const {}
    __device__ __forceinline__ void done(const Unit&) const {}
};
struct OwnTileOrder {
    int own, n, swap;
    __device__ __forceinline__ bool next(int i, Unit& u) const { if (i >= n) return false; int o = own; asm volatile("" : "+s"(o)); u.pm = swap ? i : o; u.pn = swap ? o : i; u.idx = i; return true; }
    __device__ __forceinline__ void a_ready(const Unit&) const {}
    __device__ __forceinline__ void done(const Unit&) const {}
};

__device__ __forceinline__ unsigned cvt_pk_bf16(float lo, float hi) { unsigned r; asm volatile("v_cvt_pk_bf16_f32 %0, %1, %2" : "=v"(r) : "v"(lo), "v"(hi)); return r; }

template <int ACT> struct EpiRowScale {
    static constexpr bool PERM = true, AFTER_DRAIN = false;
    bf16_t* O; int ldc; const PG8_LAS float* rst;
    __device__ __forceinline__ void operator()(const f32x4 (&acc)[2][2][4][2], const Unit& u, int wr, int wc, int fr, int fq) const {
        asm volatile("" : "+v"(fr), "+v"(fq));
        const int rl0 = wr * 64 + fr, col0 = u.pn * BM + wc * 32 + 8 * fq;
#pragma unroll
        for (int ai = 0; ai < 2; ++ai)
#pragma unroll
            for (int m = 0; m < 4; ++m) { const int rl = rl0 + ai * HALF + m * 16; bf16_t* rowp = O + (size_t)(u.pm * BM + rl) * ldc + col0;
                const float s = rst[u.idx * BM + rl];
#pragma unroll
                for (int bj = 0; bj < 2; ++bj) { f32x4 v0 = acc[ai][bj][m][0] * s, v1 = acc[ai][bj][m][1] * s;
                    if (ACT == 1) {
#pragma unroll
                        for (int e = 0; e < 4; ++e) { const float a = fmaxf(v0[e], 0.f), b = fmaxf(v1[e], 0.f); v0[e] = a * a; v1[e] = b * b; } }
                    u32x4 w; w.x = cvt_pk_bf16(v0[0], v0[1]); w.y = cvt_pk_bf16(v0[2], v0[3]); w.z = cvt_pk_bf16(v1[0], v1[1]); w.w = cvt_pk_bf16(v1[2], v1[3]);
                    __builtin_nontemporal_store(w, (u32x4*)(rowp + bj * HALF)); } }
    }
};
struct EpiColScale {
    static constexpr bool PERM = true, AFTER_DRAIN = false;
    bf16_t* O; size_t ldc; const PG8_LAS float* rs;
    __device__ __forceinline__ void operator()(const f32x4 (&acc)[2][2][4][2], const Unit& u, int wr, int wc, int fr, int fq) const {
        asm volatile("" : "+v"(fr), "+v"(fq));
        const int rl0 = wr * 64 + fr, cl0 = wc * 32 + 8 * fq;
        f32x4 sv[2][2];
#pragma unroll
        for (int bj = 0; bj < 2; ++bj)
#pragma unroll
            for (int n = 0; n < 2; ++n) sv[bj][n] = *(const PG8_LAS f32x4*)(rs + cl0 + bj * HALF + 4 * n);
#pragma unroll
        for (int ai = 0; ai < 2; ++ai)
#pragma unroll
            for (int m = 0; m < 4; ++m) { const int rl = rl0 + ai * HALF + m * 16; bf16_t* rowp = O + (size_t)(u.pm * BM + rl) * ldc + (size_t)u.pn * BM + cl0;
#pragma unroll
                for (int bj = 0; bj < 2; ++bj) { const f32x4 v0 = acc[ai][bj][m][0] * sv[bj][0], v1 = acc[ai][bj][m][1] * sv[bj][1];
                    u32x4 w; w.x = cvt_pk_bf16(v0[0], v0[1]); w.y = cvt_pk_bf16(v0[2], v0[3]); w.z = cvt_pk_bf16(v1[0], v1[1]); w.w = cvt_pk_bf16(v1[2], v1[3]);
                    *(u32x4*)(rowp + bj * HALF) = w; } }
    }
};
struct EpiRes {
    static constexpr bool PERM = true, AFTER_DRAIN = false;
    const float* res32; float* out32; bf16_t* hb; float* ssq;
    __device__ __forceinline__ void finish_half(const f32x4 (&acc)[2][2][4][2], const f32x4 (&r)[4][2][2], const Unit& u, int ai, int rl0, int col0, int wc, int fq) const {
#pragma unroll
        for (int m = 0; m < 4; ++m) { const size_t row = (size_t)(u.pm * BM + rl0 + ai * HALF + m * 16); const size_t off = row * 1024 + col0; float q = 0.f;
#pragma unroll
            for (int bj = 0; bj < 2; ++bj) {
                const f32x4 v0 = acc[ai][bj][m][0] + r[m][bj][0], v1 = acc[ai][bj][m][1] + r[m][bj][1];
                if (out32) { *(f32x4*)(out32 + off + bj * HALF) = v0; *(f32x4*)(out32 + off + bj * HALF + 4) = v1; }
                q += (v0[0] * v0[0] + v0[1] * v0[1]) + (v0[2] * v0[2] + v0[3] * v0[3]) + (v1[0] * v1[0] + v1[1] * v1[1]) + (v1[2] * v1[2] + v1[3] * v1[3]);
                u32x4 w; w.x = cvt_pk_bf16(v0[0], v0[1]); w.y = cvt_pk_bf16(v0[2], v0[3]); w.z = cvt_pk_bf16(v1[0], v1[1]); w.w = cvt_pk_bf16(v1[2], v1[3]);
                *(u32x4*)(hb + off + bj * HALF) = w; }
            q += __shfl_xor(q, 16); q += __shfl_xor(q, 32);
            if (fq == 0) ssq[row * 16 + u.pn * 4 + wc] = q; }
    }
    __device__ __forceinline__ void operator()(const f32x4 (&acc)[2][2][4][2], const Unit& u, int wr, int wc, int fr, int fq) const {
        asm volatile("" : "+v"(fr), "+v"(fq));
        const int rl0 = wr * 64 + fr, col0 = u.pn * BM + wc * 32 + 8 * fq;
        if (res32) {
#pragma unroll
            for (int ai = 0; ai < 2; ++ai) { f32x4 r[4][2][2];
#pragma unroll
                for (int m = 0; m < 4; ++m)
#pragma unroll
                    for (int bj = 0; bj < 2; ++bj) { const size_t off = (size_t)(u.pm * BM + rl0 + ai * HALF + m * 16) * 1024 + col0 + bj * HALF;
                        r[m][bj][0] = *(const f32x4*)(res32 + off); r[m][bj][1] = *(const f32x4*)(res32 + off + 4); }
                finish_half(acc, r, u, ai, rl0, col0, wc, fq); }
        } else {
            u32x4 hv[2][4][2];
#pragma unroll
            for (int ai = 0; ai < 2; ++ai)
#pragma unroll
                for (int m = 0; m < 4; ++m)
#pragma unroll
                    for (int bj = 0; bj < 2; ++bj) hv[ai][m][bj] = *(const u32x4*)(hb + (size_t)(u.pm * BM + rl0 + ai * HALF + m * 16) * 1024 + col0 + bj * HALF);
            asm volatile("" ::: "memory");
#pragma unroll
            for (int ai = 0; ai < 2; ++ai) { f32x4 r[4][2][2];
#pragma unroll
                for (int m = 0; m < 4; ++m)
#pragma unroll
                    for (int bj = 0; bj < 2; ++bj) { const u32x4 t = hv[ai][m][bj];
                        r[m][bj][0] = (f32x4){__uint_as_float(t.x << 16), __uint_as_float(t.x & 0xffff0000u), __uint_as_float(t.y << 16), __uint_as_float(t.y & 0xffff0000u)};
                        r[m][bj][1] = (f32x4){__uint_as_float(t.z << 16), __uint_as_float(t.z & 0xffff0000u), __uint_as_float(t.w << 16), __uint_as_float(t.w & 0xffff0000u)}; }
                finish_half(acc, r, u, ai, rl0, col0, wc, fq); }
        }
    }
};

template <class Epi, class Sched, bool ALIGN_EPI = false, bool SP2 = false>
__device__ __forceinline__ void gemm_phase(PG8_LAS unsigned char* lds, const Gemm g, const Sched& S, const Epi& E, int tid_in) {
    int tid_ = tid_in; asm volatile("" : "+v"(tid_));
    const int tid = tid_, wid = __builtin_amdgcn_readfirstlane(tid >> 6), lane = tid & 63, wr = wid >> 2, wc = wid & 3, fr = lane & 15, fq = lane >> 4;
    const int K = g.K, nt = K / BK;
    unsigned voffA[2], voffB[2];
#pragma unroll
    for (int i = 0; i < 2; ++i) { int R, C; stage_rc(tid * 16 + i * 8192, R, C); const int Rb = Epi::PERM ? ((R & ~31) + perm32(R & 31)) : R;
        voffA[i] = (unsigned)(R * K + C) * 2u; voffB[i] = (unsigned)(Rb * K + C) * 2u; }
    const size_t kstep = (size_t)(BK * 2);
    const size_t hstep = (size_t)HALF * K * 2;
    const size_t tstep = 2 * hstep;
    const unsigned ldsw = (unsigned)wid * 1024u;
    const int aoff = lds_byte(wr * 64 + fr, fq * 8), boff = lds_byte(wc * 32 + fr, fq * 8);
#define PG8_SA(b, h) (((b) * 2 + (h)) * HTB)
#define PG8_SB(b, h) ((4 + (b) * 2 + (h)) * HTB)
#define PG8_STAGE(bufoff, gbase, voff) do { _Pragma("unroll") for (int _i = 0; _i < 2; ++_i) \
        __builtin_amdgcn_global_load_lds((const unsigned*)((const char*)(gbase) + (voff)[_i]), (PG8_LAS unsigned*)(lds + (bufoff) + ldsw + _i * 8192), 16, 0, 0); } while (0)
#define PG8_LDA(dst, b, h) do { _Pragma("unroll") for (int m = 0; m < 4; ++m) _Pragma("unroll") for (int k = 0; k < 2; ++k) dst[m][k] = *(const PG8_LAS bf16x8*)(lds + PG8_SA(b, h) + aoff + m * 2048 + k * 1024); } while (0)
#define PG8_LDB(dst, b, h) do { _Pragma("unroll") for (int n = 0; n < 2; ++n) _Pragma("unroll") for (int k = 0; k < 2; ++k) dst[n][k] = *(const PG8_LAS bf16x8*)(lds + PG8_SB(b, h) + boff + n * 2048 + k * 1024); } while (0)
#define PG8_MMA(ai, bj, At, Bt) do { __builtin_amdgcn_s_setprio(1); _Pragma("unroll") for (int k = 0; k < 2; ++k) _Pragma("unroll") for (int m = 0; m < 4; ++m) _Pragma("unroll") for (int n = 0; n < 2; ++n) \
        acc[ai][bj][m][n] = __builtin_amdgcn_mfma_f32_16x16x32_bf16(Bt[n][k], At[m][k], acc[ai][bj][m][n], 0, 0, 0); __builtin_amdgcn_s_setprio(0); } while (0)
#define PG8_WAIT_V(n) asm volatile("s_waitcnt vmcnt(" #n ")" ::: "memory")
#define PG8_WAIT_L(n) asm volatile("s_waitcnt lgkmcnt(" #n ")" ::: "memory")
#define PG8_BAR __builtin_amdgcn_s_barrier()
#define PG8_SCHED __builtin_amdgcn_sched_barrier(0)
    Unit cur, nxt; int ui = 0;
    if (!S.next(0, cur)) return;
    f32x4 acc[2][2][4][2];
#pragma unroll
    for (int a = 0; a < 2; ++a)
#pragma unroll
        for (int b = 0; b < 2; ++b)
#pragma unroll
            for (int m = 0; m < 4; ++m)
#pragma unroll
                for (int n = 0; n < 2; ++n) acc[a][b][m][n] = (f32x4){0.f, 0.f, 0.f, 0.f};
    bf16x8 At[4][2], B0[2][2], B1[2][2];
    const char* cA = (const char*)g.A + (size_t)cur.pm * tstep; const char* cB = (const char*)g.Bt + (size_t)cur.pn * tstep;
    S.a_ready(cur);
    if constexpr (SP2) {
        PG8_STAGE(PG8_SB(0, 0), cB, voffB); PG8_STAGE(PG8_SB(0, 1), cB + hstep, voffB); PG8_STAGE(PG8_SA(0, 0), cA, voffA); PG8_STAGE(PG8_SA(0, 1), cA + hstep, voffA);
        if (wr == 1) PG8_BAR;
        PG8_WAIT_V(2); PG8_BAR;
        PG8_STAGE(PG8_SB(1, 0), cB + kstep, voffB); PG8_STAGE(PG8_SA(1, 0), cA + kstep, voffA); PG8_STAGE(PG8_SB(1, 1), cB + hstep + kstep, voffB);
        PG8_WAIT_V(6); PG8_BAR;
    } else {
        PG8_STAGE(PG8_SB(0, 0), cB, voffB); PG8_STAGE(PG8_SA(0, 0), cA, voffA); PG8_STAGE(PG8_SB(0, 1), cB + hstep, voffB); PG8_STAGE(PG8_SA(0, 1), cA + hstep, voffA);
        if (wr == 1) PG8_BAR;
        PG8_WAIT_V(4); PG8_BAR;
        PG8_STAGE(PG8_SB(1, 0), cB + kstep, voffB); PG8_STAGE(PG8_SA(1, 0), cA + kstep, voffA); PG8_STAGE(PG8_SB(1, 1), cB + hstep + kstep, voffB);
        PG8_WAIT_V(6); PG8_BAR;
    }
    for (;;) {
        const bool has_next = S.next(ui + 1, nxt);
        const char* nA = has_next ? (const char*)g.A + (size_t)nxt.pm * tstep : cA; const char* nB = has_next ? (const char*)g.Bt + (size_t)nxt.pn * tstep : cB;
        for (int t = 0; t < nt; t += 2) {
            const bool last = (t == nt - 2);
            const char* a1 = cA + (size_t)(t + 1) * kstep;
            const char* a2 = last ? nA : cA + (size_t)(t + 2) * kstep; const char* b2 = last ? nB : cB + (size_t)(t + 2) * kstep;
            const char* a3 = a2 + kstep; const char* b3 = b2 + kstep;
            if (last && has_next) S.a_ready(nxt);
            if constexpr (SP2) {
            PG8_LDB(B0, 0, 0); PG8_LDB(B1, 0, 1); PG8_SCHED; PG8_LDA(At, 0, 0); PG8_STAGE(PG8_SA(1, 1), a1 + hstep, voffA);
            PG8_WAIT_V(8); PG8_WAIT_L(0); PG8_BAR; PG8_MMA(0, 0, At, B0); PG8_MMA(0, 1, At, B1); PG8_BAR; PG8_SCHED;
            PG8_LDA(At, 0, 1); PG8_STAGE(PG8_SB(0, 0), b2, voffB); PG8_STAGE(PG8_SB(0, 1), b2 + hstep, voffB); PG8_STAGE(PG8_SA(0, 0), a2, voffA);
            PG8_WAIT_V(8); PG8_WAIT_L(0); PG8_BAR; PG8_MMA(1, 0, At, B0); PG8_MMA(1, 1, At, B1); PG8_BAR; PG8_SCHED;
            PG8_LDB(B0, 1, 0); PG8_LDB(B1, 1, 1); PG8_SCHED; PG8_LDA(At, 1, 0); PG8_STAGE(PG8_SA(0, 1), a2 + hstep, voffA);
            PG8_WAIT_V(8); PG8_WAIT_L(0); PG8_BAR; PG8_MMA(0, 0, At, B0); PG8_MMA(0, 1, At, B1); PG8_BAR; PG8_SCHED;
            PG8_LDA(At, 1, 1); PG8_STAGE(PG8_SB(1, 0), b3, voffB); PG8_STAGE(PG8_SB(1, 1), b3 + hstep, voffB); PG8_STAGE(PG8_SA(1, 0), a3, voffA);
            PG8_WAIT_V(8); PG8_WAIT_L(0); PG8_BAR; PG8_MMA(1, 0, At, B0); PG8_MMA(1, 1, At, B1); PG8_BAR; PG8_SCHED;
            } else {
            PG8_LDB(B0, 0, 0); PG8_SCHED; PG8_LDA(At, 0, 0); PG8_STAGE(PG8_SA(1, 1), a1 + hstep, voffA);
            PG8_WAIT_L(8); PG8_BAR; PG8_WAIT_L(0); PG8_MMA(0, 0, At, B0); PG8_BAR; PG8_SCHED;
            PG8_LDB(B1, 0, 1); PG8_STAGE(PG8_SB(0, 0), b2, voffB);
            PG8_BAR; PG8_WAIT_L(0); PG8_MMA(0, 1, At, B1); PG8_BAR;
            PG8_LDA(At, 0, 1); PG8_STAGE(PG8_SA(0, 0), a2, voffA);
            PG8_BAR; PG8_WAIT_L(0); PG8_MMA(1, 0, At, B0); PG8_BAR; PG8_SCHED;
            PG8_STAGE(PG8_SB(0, 1), b2 + hstep, voffB);
            PG8_WAIT_V(6); PG8_BAR; PG8_MMA(1, 1, At, B1); PG8_BAR;
            PG8_LDB(B0, 1, 0); PG8_SCHED; PG8_LDA(At, 1, 0); PG8_STAGE(PG8_SA(0, 1), a2 + hstep, voffA);
            PG8_WAIT_L(8); PG8_BAR; PG8_WAIT_L(0); PG8_MMA(0, 0, At, B0); PG8_BAR; PG8_SCHED;
            PG8_LDB(B1, 1, 1); PG8_STAGE(PG8_SB(1, 0), b3, voffB);
            PG8_BAR; PG8_WAIT_L(0); PG8_MMA(0, 1, At, B1); PG8_BAR;
            PG8_LDA(At, 1, 1); PG8_STAGE(PG8_SA(1, 0), a3, voffA);
            PG8_BAR; PG8_WAIT_L(0); PG8_MMA(1, 0, At, B0); PG8_BAR; PG8_SCHED;
            PG8_STAGE(PG8_SB(1, 1), b3 + hstep, voffB);
            PG8_WAIT_V(6); PG8_BAR; PG8_MMA(1, 1, At, B1); PG8_BAR;
            }
        }
        if constexpr (ALIGN_EPI) { if (wr == 0) PG8_BAR; }
        if constexpr (!Epi::AFTER_DRAIN) { E(acc, cur, wr, wc, fr, fq); S.done(cur); }
        if (!has_next) break;
#pragma unroll
        for (int a = 0; a < 2; ++a)
#pragma unroll
            for (int b = 0; b < 2; ++b)
#pragma unroll
                for (int m = 0; m < 4; ++m)
#pragma unroll
                    for (int n = 0; n < 2; ++n) acc[a][b][m][n] = (f32x4){0.f, 0.f, 0.f, 0.f};
        cur = nxt; cA = nA; cB = nB; ++ui;
        if constexpr (ALIGN_EPI) { if (wr == 1) PG8_BAR; }
    }
    PG8_WAIT_V(0);
    if constexpr (!ALIGN_EPI) { if (wr == 0) PG8_BAR; }
    PG8_BAR;
#undef PG8_SA
#undef PG8_SB
#undef PG8_STAGE
#undef PG8_LDA
#undef PG8_LDB
#undef PG8_MMA
#undef PG8_WAIT_V
#undef PG8_WAIT_L
#undef PG8_BAR
#undef PG8_SCHED
}
}

constexpr int NB = 32, SEQ = 2048, D = 1024, NMETA = 16, DEPTH = 2;
constexpr int MT = NB * SEQ;
constexpr int INW = 2560, UW = 2048, FF = 4096;
constexpr int LPOS = NMETA + SEQ;
constexpr float EPS = 1e-6f;
constexpr int NWAVES = 8, NTHREADS = 512;

typedef unsigned short bf16;
typedef short bf16x8 __attribute__((ext_vector_type(8)));
typedef float f32x4 __attribute__((ext_vector_type(4)));
typedef float f32x16 __attribute__((ext_vector_type(16)));
typedef unsigned u32x4 __attribute__((ext_vector_type(4)));
typedef unsigned u32x2 __attribute__((ext_vector_type(2)));
#define LAS __attribute__((address_space(3)))

constexpr size_t MiB = 1u << 20;
constexpr size_t WS_CTL = 0, CTL_ZERO_BYTES = 65536; constexpr int CW_BAR = 1024;
constexpr size_t WS_W = 1 * MiB;
constexpr size_t W_LAYER = 23 * MiB, W_IN = 0, W_OUT = 5 * MiB, W_UP = 7 * MiB, W_DN = 15 * MiB;
constexpr size_t WS_META = 47 * MiB;
constexpr size_t MB_HM = 0, MB_HMB = 64 * 1024, MB_UM = 96 * 1024, MB_VTM = 176 * 1024, MB_MIXM = 192 * 1024, MB_HIDM = 224 * 1024, MB_SSQM = 352 * 1024;
constexpr size_t WS_SSQ = 48 * MiB;
constexpr size_t WS_HB = 52 * MiB;
constexpr size_t WS_U = 180 * MiB;
constexpr size_t WS_VT = 436 * MiB;
constexpr size_t WS_MIX = 500 * MiB;
constexpr size_t WS_HID = 180 * MiB;
constexpr size_t WS_END = 692 * MiB;

constexpr int LDS_STAGE = 147456, LDS_RS = LDS_STAGE, LDS_BYTES = LDS_STAGE + 2048;

__device__ __forceinline__ float bf2f(unsigned short h) { return __uint_as_float((unsigned)h << 16); }
__device__ __forceinline__ unsigned pk2(float lo, float hi) { return pg8::cvt_pk_bf16(lo, hi); }
__device__ __forceinline__ float wave_sum(float v) {
#pragma unroll
    for (int o = 1; o < 64; o <<= 1) v += __shfl_xor(v, o);
    return v;
}

struct Args {
    const float *x, *meta, *g_mix, *w_in, *w_conv, *w_pool, *pool_scale, *w_out, *g_mlp, *w_up, *w_down, *g_final;
    float* out; unsigned char* ws;
};

__device__ __forceinline__ void tile_writeout(LAS float* scr, bf16* WT, int K, int row0, int k0, int lane) {
    const int c = lane & 7;
#pragma unroll
    for (int j = 0; j < 4; ++j) { const int n = (lane >> 3) + 8 * j; const LAS float* s = scr + (8 * c) * 33 + n;
        u32x4 o; o.x = pk2(s[0 * 33], s[1 * 33]); o.y = pk2(s[2 * 33], s[3 * 33]); o.z = pk2(s[4 * 33], s[5 * 33]); o.w = pk2(s[6 * 33], s[7 * 33]);
        *(u32x4*)(WT + (size_t)(row0 + n) * K + k0 + 8 * c) = o; }
    asm volatile("s_waitcnt lgkmcnt(0)" ::: "memory");
}
#define GAS __attribute__((address_space(1)))
__device__ __forceinline__ void transpose_item(const float* W_, int K, int N, bf16* WT, const float* gk_, float cs, LAS float* scr, int kb, int nb, int lane) {
    const int k0 = 64 * kb, n0 = 32 * nb; const GAS float* W = (const GAS float*)W_; const GAS float* gk = (const GAS float*)gk_;
    float wv[32];
#pragma unroll
    for (int i = 0; i < 32; ++i) wv[i] = W[(size_t)(k0 + 2 * i + (lane >> 5)) * N + n0 + (lane & 31)];
#pragma unroll
    for (int i = 0; i < 32; ++i) { const int kk = 2 * i + (lane >> 5); const float gv = gk_ ? gk[k0 + kk] : 1.f;
        scr[kk * 33 + (lane & 31)] = wv[i] * gv * cs; }
    asm volatile("s_waitcnt lgkmcnt(0)" ::: "memory");
    tile_writeout(scr, WT, K, n0, k0, lane);
}
__device__ __forceinline__ void poolfold_item(const float* Win_, const float* wp_, const float* scale, const float* gk, bf16* WT, LAS float* scr, int kb, int nb, int lane) {
    const int k0 = 64 * kb, g = nb >> 1, d = (nb & 1) * 32 + (lane & 31), kh = lane >> 5; const GAS float* Win = (const GAS float*)Win_; const GAS float* wp = (const GAS float*)wp_;
#pragma unroll 32
    for (int i = 0; i < 64; ++i) scr[i * 64 + lane] = Win[(size_t)(k0 + i) * INW + 768 + 64 * g + lane];
    const GAS float* wpc = wp + (size_t)g * 4096 + d;
    float wreg[64];
#pragma unroll
    for (int c = 0; c < 64; ++c) wreg[c] = wpc[c * 64];
    asm volatile("s_waitcnt lgkmcnt(0)" ::: "memory");
    float accv[32];
#pragma unroll
    for (int kk = 0; kk < 32; ++kk) accv[kk] = 0.f;
#pragma unroll
    for (int c = 0; c < 64; c += 4) {
        const float w0 = wreg[c], w1 = wreg[c + 1], w2 = wreg[c + 2], w3 = wreg[c + 3];
#pragma unroll
        for (int kk = 0; kk < 32; ++kk) { const f32x4 a = *(const LAS f32x4*)(scr + (2 * kk + kh) * 64 + c); accv[kk] += (a[0] * w0 + a[1] * w1) + (a[2] * w2 + a[3] * w3); }
    }
    const float sc = scale[64 * g + d];
    asm volatile("s_waitcnt lgkmcnt(0)" ::: "memory");
#pragma unroll
    for (int kk = 0; kk < 32; ++kk) { const int k = 2 * kk + kh; scr[k * 33 + (lane & 31)] = accv[kk] * sc * gk[k0 + k]; }
    asm volatile("s_waitcnt lgkmcnt(0)" ::: "memory");
    tile_writeout(scr, WT, D, 768 + 32 * nb, k0, lane);
}

constexpr float QSCALE = 0.125f * 1.4426950408889634f;

__device__ __forceinline__ void prologue(const Args& a, LAS unsigned char* lds, int w, int G, int wave, int lane) {
    LAS float* scr = (LAS float*)(lds + wave * 16384);
    const int gw = w * NWAVES + wave, NGW = G * NWAVES;
    constexpr int I_IN = 16 * 80, I_OUT = 16 * 32, I_UP = 16 * 128, I_DN = 64 * 32, I_L = I_IN + I_OUT + I_UP + I_DN;
    for (int it = gw; it < DEPTH * I_L; it += NGW) {
        const int l = it / I_L; int r = it % I_L;
        unsigned char* wl = a.ws + WS_W + (size_t)l * W_LAYER;
        if (r < I_IN) { const int kb = r / 80, nb = r % 80; const float* Win = a.w_in + (size_t)l * D * INW; const float* gk = a.g_mix + l * D;
            if (nb >= 24 && nb < 32) poolfold_item(Win, a.w_pool + (size_t)l * 4 * 4096, a.pool_scale + l * 256, gk, (bf16*)(wl + W_IN), scr, kb, nb - 24, lane);
            else transpose_item(Win, D, INW, (bf16*)(wl + W_IN), gk, (nb >= 32 && nb < 48) ? QSCALE : 1.f, scr, kb, nb, lane);
            continue; }
        r -= I_IN;
        if (r < I_OUT) { transpose_item(a.w_out + (size_t)l * D * D, D, D, (bf16*)(wl + W_OUT), nullptr, 1.f, scr, r / 32, r % 32, lane); continue; }
        r -= I_OUT;
        if (r < I_UP) { transpose_item(a.w_up + (size_t)l * D * FF, D, FF, (bf16*)(wl + W_UP), a.g_mlp + l * D, 1.f, scr, r / 128, r % 128, lane); continue; }
        r -= I_UP;
        transpose_item(a.w_down + (size_t)l * FF * D, FF, D, (bf16*)(wl + W_DN), nullptr, 1.f, scr, r / 32, r % 32, lane);
    }
    bf16* hb = (bf16*)(a.ws + WS_HB); float* ssq = (float*)(a.ws + WS_SSQ);
    for (int i = wave * 4; i < 256; i += NWAVES * 4) { const size_t row = (size_t)w * 256 + i;
        const f32x4* xr = (const f32x4*)(a.x + row * D) + lane; f32x4 v[4][4]; float sq[4];
#pragma unroll
        for (int r = 0; r < 4; ++r)
#pragma unroll
            for (int j = 0; j < 4; ++j) v[r][j] = __builtin_nontemporal_load(xr + r * 256 + 64 * j);
#pragma unroll
        for (int r = 0; r < 4; ++r) { float s = 0.f;
#pragma unroll
            for (int j = 0; j < 4; ++j) s += (v[r][j][0] * v[r][j][0] + v[r][j][1] * v[r][j][1]) + (v[r][j][2] * v[r][j][2] + v[r][j][3] * v[r][j][3]);
            sq[r] = wave_sum(s); }
#pragma unroll
        for (int r = 0; r < 4; ++r) { u32x2* o8 = (u32x2*)(hb + (row + r) * D) + lane;
#pragma unroll
            for (int j = 0; j < 4; ++j) { u32x2 o; o.x = pk2(v[r][j][0], v[r][j][1]); o.y = pk2(v[r][j][2], v[r][j][3]); o8[64 * j] = o; }
            if (lane < 16) ssq[(row + r) * 16 + lane] = lane == 0 ? sq[r] : 0.f; } }
    if (w == 0) { unsigned char* mb = a.ws + WS_META; float* hm = (float*)(mb + MB_HM); bf16* hmb = (bf16*)(mb + MB_HMB); float* ssqm = (float*)(mb + MB_SSQM);
        for (int row = wave; row < NMETA; row += NWAVES) { const f32x4* xr = (const f32x4*)(a.meta + row * D) + lane; float s = 0.f;
#pragma unroll
            for (int j = 0; j < 4; ++j) { const f32x4 v = xr[64 * j]; s += (v[0] * v[0] + v[1] * v[1]) + (v[2] * v[2] + v[3] * v[3]);
                ((f32x4*)(hm + row * D))[lane + 64 * j] = v; u32x2 o; o.x = pk2(v[0], v[1]); o.y = pk2(v[2], v[3]); ((u32x2*)(hmb + row * D))[lane + 64 * j] = o; }
            s = wave_sum(s); ssqm[row * 64 + lane] = lane == 0 ? s : 0.f; } }
}

template <class F> __device__ __forceinline__ void meta_gemm(const bf16* A, const bf16* Bt, int N, int K, int w, int G, int wave, int lane, LAS unsigned char* lds, F epi) {
    const int fr = lane & 15, fq = lane >> 4, kc = K / 8;
    for (int tile = w; tile < N / 16; tile += G) {
        const bf16x8* ap = (const bf16x8*)(A + (size_t)fr * K + wave * kc + fq * 8); const bf16x8* bp = (const bf16x8*)(Bt + (size_t)(tile * 16 + fr) * K + wave * kc + fq * 8);
        f32x4 acc0 = {0.f, 0.f, 0.f, 0.f}, acc1 = {0.f, 0.f, 0.f, 0.f};
        for (int kk = 0; kk < kc / 32; kk += 4) {
            const bf16x8 a0 = ap[(kk + 0) * 4], a1 = ap[(kk + 1) * 4], a2 = ap[(kk + 2) * 4], a3 = ap[(kk + 3) * 4];
            const bf16x8 b0 = bp[(kk + 0) * 4], b1 = bp[(kk + 1) * 4], b2 = bp[(kk + 2) * 4], b3 = bp[(kk + 3) * 4];
            acc0 = __builtin_amdgcn_mfma_f32_16x16x32_bf16(b0, a0, acc0, 0, 0, 0); acc1 = __builtin_amdgcn_mfma_f32_16x16x32_bf16(b1, a1, acc1, 0, 0, 0);
            acc0 = __builtin_amdgcn_mfma_f32_16x16x32_bf16(b2, a2, acc0, 0, 0, 0); acc1 = __builtin_amdgcn_mfma_f32_16x16x32_bf16(b3, a3, acc1, 0, 0, 0);
        }
        LAS f32x4* red = (LAS f32x4*)lds;
        red[wave * 64 + lane] = acc0 + acc1;
        __syncthreads();
        if (wave == 0) { f32x4 t = red[lane];
#pragma unroll
            for (int j = 1; j < 8; ++j) t += red[j * 64 + lane];
            epi(tile, fr, fq, t); }
        __syncthreads();
    }
}
__device__ __forceinline__ float meta_rstd(const float* ssqm, int lane) {
    const int fr = lane & 15, fq = lane >> 4; const f32x4* p = (const f32x4*)(ssqm + fr * 64 + fq * 16); float s = 0.f;
#pragma unroll
    for (int j = 0; j < 4; ++j) { const f32x4 v = p[j]; s += (v[0] + v[1]) + (v[2] + v[3]); }
    s += __shfl_xor(s, 16); s += __shfl_xor(s, 32);
    return 1.0f / sqrtf(s * (1.0f / D) + EPS);
}

__device__ __forceinline__ const bf16* urow(const bf16* u, const bf16* um, int b, int p) { return p < NMETA ? um + (size_t)p * UW : u + ((size_t)b * SEQ + (p - NMETA)) * UW; }
__device__ __forceinline__ void ld8(const bf16* p, float (&v)[8]) { const u32x4 r = *(const u32x4*)p;
    v[0] = __uint_as_float(r.x << 16); v[1] = __uint_as_float(r.x & 0xffff0000u); v[2] = __uint_as_float(r.y << 16); v[3] = __uint_as_float(r.y & 0xffff0000u);
    v[4] = __uint_as_float(r.z << 16); v[5] = __uint_as_float(r.z & 0xffff0000u); v[6] = __uint_as_float(r.w << 16); v[7] = __uint_as_float(r.w & 0xffff0000u); }
__device__ __forceinline__ void st8(bf16* p, const float (&v)[8]) { u32x4 o; o.x = pk2(v[0], v[1]); o.y = pk2(v[2], v[3]); o.z = pk2(v[4], v[5]); o.w = pk2(v[6], v[7]); *(u32x4*)p = o; }

__device__ __forceinline__ void up8(const u32x4 r, float (&v)[8]) {
    v[0] = __uint_as_float(r.x << 16); v[1] = __uint_as_float(r.x & 0xffff0000u); v[2] = __uint_as_float(r.y << 16); v[3] = __uint_as_float(r.y & 0xffff0000u);
    v[4] = __uint_as_float(r.z << 16); v[5] = __uint_as_float(r.z & 0xffff0000u); v[6] = __uint_as_float(r.w << 16); v[7] = __uint_as_float(r.w & 0xffff0000u); }
__device__ __forceinline__ void mix_convpool(const Args& a, unsigned char* ws, int l, int w, int tid) {
    const bf16* u = (const bf16*)(ws + WS_U); const bf16* um = (const bf16*)(ws + WS_META + MB_UM); bf16* mix = (bf16*)(ws + WS_MIX);
    const int b = w >> 3, j = w & 7, ch = (tid & 31) * 8, rg = tid >> 5, p0 = NMETA + 256 * j + rg * 16;
    const float* wc = a.w_conv + (size_t)l * 3 * 256 + ch; float w0[8], w1[8], w2[8], g2[8], g1[8], s[8], t0[8], t1[8];
    const int W = 2 << (ch >> 6); const float invW = 1.0f / (float)W;
#pragma unroll
    for (int e = 0; e < 8; ++e) { w0[e] = wc[e]; w1[e] = wc[256 + e]; w2[e] = wc[512 + e]; s[e] = 0.f; }
    {
        u32x4 hc[4], hz[15];
        { const bf16* r = urow(u, um, b, p0 - 2); hc[0] = *(const u32x4*)(r + 256 + ch); hc[1] = *(const u32x4*)(r + 512 + ch);
          r = urow(u, um, b, p0 - 1); hc[2] = *(const u32x4*)(r + 256 + ch); hc[3] = *(const u32x4*)(r + 512 + ch); }
#pragma unroll
        for (int k = 1; k < 16; ++k) hz[k - 1] = *(const u32x4*)(urow(u, um, b, p0 - (k < W ? k : 1)) + 768 + ch);
        up8(hc[0], t0); up8(hc[1], t1);
#pragma unroll
        for (int e = 0; e < 8; ++e) g2[e] = t0[e] * t1[e];
        up8(hc[2], t0); up8(hc[3], t1);
#pragma unroll
        for (int e = 0; e < 8; ++e) g1[e] = t0[e] * t1[e];
#pragma unroll
        for (int k = 1; k < 16; ++k) { up8(hz[k - 1], t0);
#pragma unroll
            for (int e = 0; e < 8; ++e) s[e] += (k < W) ? t0[e] : 0.f; }
    }
#pragma nounroll
    for (int hb4 = 0; hb4 < 16; hb4 += 4) {
        u32x4 rb[4], rc[4], rx[4], rz[4], ro[4];
#pragma unroll
        for (int i = 0; i < 4; ++i) { const int p = p0 + hb4 + i; const bf16* r = urow(u, um, b, p);
            rb[i] = *(const u32x4*)(r + ch); rc[i] = *(const u32x4*)(r + 256 + ch); rx[i] = *(const u32x4*)(r + 512 + ch); rz[i] = *(const u32x4*)(r + 768 + ch);
            ro[i] = *(const u32x4*)(urow(u, um, b, p - W + 1) + 768 + ch); }
        asm volatile("" ::: "memory");
#pragma unroll
        for (int i = 0; i < 4; ++i) { const int p = p0 + hb4 + i; float cb[8], y[8]; bf16* orow = mix + ((size_t)b * SEQ + (p - NMETA)) * D;
            up8(rb[i], cb); up8(rc[i], t0); up8(rx[i], t1);
#pragma unroll
            for (int e = 0; e < 8; ++e) { const float g0 = t0[e] * t1[e]; y[e] = cb[e] * (w0[e] * g2[e] + w1[e] * g1[e] + w2[e] * g0); g2[e] = g1[e]; g1[e] = g0; }
            st8(orow + ch, y);
            up8(rz[i], t0); up8(ro[i], t1);
#pragma unroll
            for (int e = 0; e < 8; ++e) { s[e] += t0[e]; y[e] = s[e] * invW - t0[e]; s[e] -= t1[e]; }
            st8(orow + 256 + ch, y); }
    }
}
__device__ __forceinline__ void mix_convpool_meta(const Args& a, unsigned char* ws, int l, int tid) {
    const bf16* um = (const bf16*)(ws + WS_META + MB_UM); bf16* mixm = (bf16*)(ws + WS_META + MB_MIXM);
    if (tid < 256) { const int c = tid; const float* wc = a.w_conv + (size_t)l * 3 * 256 + c; const float w0 = wc[0], w1 = wc[256], w2 = wc[512];
        unsigned short rb[16], rc[16], rx[16];
#pragma unroll
        for (int p = 0; p < NMETA; ++p) { const bf16* r = um + p * UW; rb[p] = r[c]; rc[p] = r[256 + c]; rx[p] = r[512 + c]; }
        float g2 = 0.f, g1 = 0.f;
#pragma unroll
        for (int p = 0; p < NMETA; ++p) { const float g0 = bf2f(rc[p]) * bf2f(rx[p]); const float y = bf2f(rb[p]) * (w0 * g2 + w1 * g1 + w2 * g0); g2 = g1; g1 = g0;
            mixm[p * D + c] = (bf16)(pk2(y, 0.f) & 0xffffu); } }
    else { const int c = tid - 256; const int W = 2 << (c >> 6);
        float z[16];
#pragma unroll
        for (int p = 0; p < NMETA; ++p) z[p] = bf2f(um[p * UW + 768 + c]);
#pragma unroll
        for (int p = 0; p < NMETA; ++p) { const int cnt = (p + 1 < W) ? p + 1 : W; float s = 0.f;
#pragma unroll
            for (int k = 0; k <= p; ++k) s += (k < W) ? z[p - k] : 0.f;
            const float y = s / (float)cnt - z[p]; mixm[p * D + 256 + c] = (bf16)(pk2(y, 0.f) & 0xffffu); } }
}

constexpr int AT_PITCH = 144, AT_TILE = 64 * AT_PITCH, AT_NT = 7, AT_KOFF = 0, AT_VOFF = AT_NT * AT_TILE;
struct AttnState { f32x16 o0, o1; float carry; };
__device__ __forceinline__ void attn_tile_scores(AttnState& st, u32x4 (&pw)[4], const bf16x8 (&qf)[4], const bf16x8 (&kf)[2][4], int kv0, int P0, int pq, int hi) {
    f32x16 s0 = {}, s1 = {};
#pragma unroll
    for (int d0 = 0; d0 < 4; ++d0) { s0 = __builtin_amdgcn_mfma_f32_32x32x16_bf16(kf[0][d0], qf[d0], s0, 0, 0, 0); s1 = __builtin_amdgcn_mfma_f32_32x32x16_bf16(kf[1][d0], qf[d0], s1, 0, 0, 0); }
    const int kb = kv0 + 32 * hi;
    if (kv0 + 64 > P0) { const int lim = pq - kb - 1;
#pragma unroll
        for (int r = 0; r < 16; ++r) { const int m0 = lim - r, m1 = lim - 16 - r;
            s0[r] = __builtin_fmaf((float)(m0 < 0 ? m0 : 0), 1e30f, s0[r]); s1[r] = __builtin_fmaf((float)(m1 < 0 ? m1 : 0), 1e30f, s1[r]); } }
    f32x16 k0v, k1v; float p0 = 1.f, p1 = 1.f, p2 = 1.f, p3 = 1.f;
#pragma unroll
    for (int r = 0; r < 16; ++r) { k0v[r] = __builtin_amdgcn_rcpf(1.0f + __builtin_amdgcn_exp2f(s0[r])); k1v[r] = __builtin_amdgcn_rcpf(1.0f + __builtin_amdgcn_exp2f(s1[r])); }
#pragma unroll
    for (int r = 0; r < 16; r += 2) { p0 *= k0v[r]; p1 *= k0v[r + 1]; p2 *= k1v[r]; p3 *= k1v[r + 1]; }
    const float tot = (p0 * p1) * (p2 * p3);
    const float oth = __shfl_xor(tot, 32);
    float run = hi ? st.carry : st.carry * oth;
    st.carry = st.carry * (tot * oth);
#pragma unroll
    for (int r = 15; r >= 0; --r) { s1[r] = (1.0f - k1v[r]) * run; run *= k1v[r]; }
#pragma unroll
    for (int r = 15; r >= 0; --r) { s0[r] = (1.0f - k0v[r]) * run; run *= k0v[r]; }
    pw[0] = (u32x4){pk2(s0[0], s0[1]), pk2(s0[2], s0[3]), pk2(s0[4], s0[5]), pk2(s0[6], s0[7])};
    pw[1] = (u32x4){pk2(s0[8], s0[9]), pk2(s0[10], s0[11]), pk2(s0[12], s0[13]), pk2(s0[14], s0[15])};
    pw[2] = (u32x4){pk2(s1[0], s1[1]), pk2(s1[2], s1[3]), pk2(s1[4], s1[5]), pk2(s1[6], s1[7])};
    pw[3] = (u32x4){pk2(s1[8], s1[9]), pk2(s1[10], s1[11]), pk2(s1[12], s1[13]), pk2(s1[14], s1[15])};
}
__device__ __forceinline__ bool attn_tile_pv(AttnState& st, const u32x4 (&pw)[4], const bf16x8 (&vf)[2][4]) {
#pragma unroll
    for (int c = 0; c < 4; ++c) { const bf16x8 pf = __builtin_bit_cast(bf16x8, pw[c]);
        st.o0 = __builtin_amdgcn_mfma_f32_32x32x16_bf16(vf[0][c], pf, st.o0, 0, 0, 0); st.o1 = __builtin_amdgcn_mfma_f32_32x32x16_bf16(vf[1][c], pf, st.o1, 0, 0, 0); }
    return __all(st.carry < 1.1754944e-38f) != 0;
}
__device__ __forceinline__ void attn_stage_load(u32x4 (&kx)[AT_NT], u32x4 (&vx)[AT_NT], const bf16* __restrict__ u, const bf16* __restrict__ um, const bf16* __restrict__ vT, const bf16* __restrict__ vTm,
                                                int b, int h, int Tlo, int tid) {
    const int rr = tid >> 3, ch = tid & 7;
#pragma unroll
    for (int s = 0; s < AT_NT; ++s) {
        int pk = (Tlo + s) * 64 + rr; pk = pk < LPOS ? pk : LPOS - 1;
        kx[s] = *(const u32x4*)(urow(u, um, b, pk) + 1536 + h * 64 + ch * 8);
        int pv = (Tlo + s) * 64 + 8 * ch; pv = pv < LPOS - 8 ? pv : LPOS - 8;
        const int dr = h * 64 + rr;
        vx[s] = *(const u32x4*)(pv < NMETA ? vTm + dr * 16 + pv : vT + (size_t)dr * MT + (size_t)b * SEQ + (pv - NMETA)); }
}
__device__ __forceinline__ void attn_stage_store(LAS unsigned char* lds, const u32x4 (&kx)[AT_NT], const u32x4 (&vx)[AT_NT], int tid) {
    const int rr = tid >> 3, ch = tid & 7;
    const int krow = 32 * ((rr >> 4) & 1) + (rr & 3) + 8 * ((rr & 15) >> 2) + 4 * (rr >> 5);
#pragma unroll
    for (int s = 0; s < AT_NT; ++s) {
        *(LAS u32x4*)(lds + AT_KOFF + s * AT_TILE + krow * AT_PITCH + ch * 16) = kx[s];
        *(LAS u32x4*)(lds + AT_VOFF + s * AT_TILE + rr * AT_PITCH + ch * 16) = vx[s]; }
}
__device__ __forceinline__ void sb_attn_wave(LAS unsigned char* lds, int Tlo, const bf16* __restrict__ u, const bf16* __restrict__ um, const bf16* __restrict__ vT, const bf16* __restrict__ vTm,
                                             int b, int h, int P0, const bf16x8 (&qf)[4], bf16* orow  , int lane) {
    const int r32 = lane & 31, hi = lane >> 5;
    const int pq = P0 + r32;
    AttnState st; st.o0 = (f32x16){}; st.o1 = (f32x16){}; st.carry = 1.f;
    bool done = false;
    int t = (P0 + 30) >> 6;
    const LAS unsigned char* kbase = lds + AT_KOFF + r32 * AT_PITCH + hi * 16;
    const LAS unsigned char* vbase = lds + AT_VOFF + r32 * AT_PITCH + hi * 64;
    const int key0 = 32 * ((r32 >> 2) & 1) + (r32 & 3) + 4 * (r32 >> 3);
#pragma nounroll
    for (; t >= Tlo && !done; --t) {
        const int so = (t - Tlo) * AT_TILE;
        bf16x8 kf[2][4], vf[2][4]; u32x4 pw[4];
#pragma unroll
        for (int hf = 0; hf < 2; ++hf)
#pragma unroll
            for (int d0 = 0; d0 < 4; ++d0) kf[hf][d0] = *(const LAS bf16x8*)(kbase + so + hf * 32 * AT_PITCH + d0 * 32);
        attn_tile_scores(st, pw, qf, kf, t * 64, P0, pq, hi);
        __builtin_amdgcn_sched_barrier(0);
#pragma unroll
        for (int dh = 0; dh < 2; ++dh)
#pragma unroll
            for (int c = 0; c < 4; ++c) vf[dh][c] = *(const LAS bf16x8*)(vbase + so + dh * 32 * AT_PITCH + c * 16);
        done = attn_tile_pv(st, pw, vf);
    }
#pragma nounroll
    for (; t >= 0 && !done; --t) {
        const int kv0 = t * 64;
        bf16x8 kf[2][4], vf[2][4]; u32x4 pw[4];
#pragma unroll
        for (int hf = 0; hf < 2; ++hf) { int pk = kv0 + key0 + 16 * hf; pk = pk < LPOS ? pk : LPOS - 1; const bf16* kr = urow(u, um, b, pk) + 1536 + h * 64 + 8 * hi;
#pragma unroll
            for (int d0 = 0; d0 < 4; ++d0) kf[hf][d0] = *(const bf16x8*)(kr + 16 * d0); }
#pragma unroll
        for (int c = 0; c < 4; ++c) { int pv = kv0 + 32 * hi + 8 * c; pv = pv < LPOS - 8 ? pv : LPOS - 8;
#pragma unroll
            for (int dh = 0; dh < 2; ++dh) { const int dr = h * 64 + dh * 32 + r32;
                const bf16* vp = pv < NMETA ? vTm + dr * 16 + pv : vT + (size_t)dr * MT + (size_t)b * SEQ + (pv - NMETA);
                vf[dh][c] = *(const bf16x8*)vp; } }
        attn_tile_scores(st, pw, qf, kf, kv0, P0, pq, hi);
        done = attn_tile_pv(st, pw, vf);
    }
    if (orow) { bf16* op = orow + h * 64 + 4 * hi;
#pragma unroll
        for (int g = 0; g < 4; ++g) { u32x2 w0, w1; w0.x = pk2(st.o0[4 * g], st.o0[4 * g + 1]); w0.y = pk2(st.o0[4 * g + 2], st.o0[4 * g + 3]); w1.x = pk2(st.o1[4 * g], st.o1[4 * g + 1]); w1.y = pk2(st.o1[4 * g + 2], st.o1[4 * g + 3]);
            *(u32x2*)(op + 8 * g) = w0; *(u32x2*)(op + 32 + 8 * g) = w1; } }
}

#define XB_TMO      128
#define XB_XCNT(j)  (256  + 64 * (j))
#define XB_XSUB(j)  (1280 + 64 * (j))
#define XB_XGEN(j)  (2304 + 64 * (j))
#define XB_TOP      3328
#define XB_TOPGEN   3392
#define XCD_BAR_WORDS 3456
#define XB_SPIN_CAP (1u << 18)
__device__ __forceinline__ unsigned xb_ld(unsigned* p)              { return __hip_atomic_load(p, __ATOMIC_RELAXED, __HIP_MEMORY_SCOPE_AGENT); }
__device__ __forceinline__ unsigned xb_add(unsigned* p, unsigned v) { return __hip_atomic_fetch_add(p, v, __ATOMIC_RELAXED, __HIP_MEMORY_SCOPE_AGENT); }
__device__ __forceinline__ unsigned xb_xcc_id() { return (unsigned)__builtin_amdgcn_s_getreg((3 << 11) | 20) & 0xFu; }
#define XB_SPIN(cond, bar) do { unsigned _sp = 0; while (cond) { __builtin_amdgcn_s_sleep(1); \
    if ((++_sp & 255u) == 0u) { if (xb_ld(&(bar)[XB_TMO])) break; if (_sp > XB_SPIN_CAP) { atomicAdd(&(bar)[XB_TMO], 1u); break; } } } } while (0)
struct XcdBarrier { unsigned* bar; unsigned x; volatile LAS unsigned* st; };
__device__ __forceinline__ XcdBarrier xcd_barrier_post(unsigned* bar, volatile LAS unsigned* st, bool leader) {
    XcdBarrier b; b.bar = bar; b.x = xb_xcc_id(); b.st = st;
    if (leader) (void)xb_add(&bar[XB_XCNT(b.x)], 1u);
    return b;
}
__device__ __forceinline__ void xcd_barrier_complete(unsigned* bar, unsigned x, unsigned& nloc, unsigned& nx) {
    const unsigned G = gridDim.x * gridDim.y * gridDim.z;
    unsigned sum, cnt, mine, sp = 0u;
    for (;;) {
        sum = 0u; cnt = 0u; mine = 0u;
#pragma unroll
        for (unsigned j = 0; j < 16; ++j) { const unsigned c = xb_ld(&bar[XB_XCNT(j)]); sum += c; cnt += (c > 0u) ? 1u : 0u; mine = (j == x) ? c : mine; }
        if (sum == G) break;
        __builtin_amdgcn_s_sleep(1);
        if ((++sp & 255u) == 0u) { if (xb_ld(&bar[XB_TMO])) break; if (sp > XB_SPIN_CAP) { atomicAdd(&bar[XB_TMO], 1u); break; } }
    }
    nloc = mine > 0u ? mine : 1u; nx = cnt > 0u ? cnt : 1u;
}
__device__ __forceinline__ void xcd_barrier(const XcdBarrier& b, bool leader  ) {
    asm volatile("s_waitcnt vmcnt(0)" ::: "memory");
    __syncthreads();
    if (leader) {
        unsigned* bar = b.bar;
        __builtin_amdgcn_s_waitcnt(0);
        unsigned nloc = b.st[0], nx = b.st[1];
        if (nloc == 0u) { xcd_barrier_complete(bar, b.x, nloc, nx); b.st[0] = nloc; b.st[1] = nx; }
        const unsigned old = xb_add(&bar[XB_XSUB(b.x)], 1u);
        const unsigned gen = old / nloc;
        if (old + 1u == (gen + 1u) * nloc) {
            __builtin_amdgcn_fence(__ATOMIC_RELEASE, "agent");
            asm volatile("s_waitcnt vmcnt(0)" ::: "memory");
            const unsigned og = xb_add(&bar[XB_TOP], 1u);
            const unsigned tg = og / nx;
            if (og + 1u == (tg + 1u) * nx) xb_add(&bar[XB_TOPGEN], 1u);
            else XB_SPIN(xb_ld(&bar[XB_TOPGEN]) == tg, bar);
            __builtin_amdgcn_fence(__ATOMIC_ACQUIRE, "agent");
            xb_add(&bar[XB_XGEN(b.x)], 1u);
            asm volatile("s_waitcnt vmcnt(0)" ::: "memory");
        } else {
            XB_SPIN(xb_ld(&bar[XB_XGEN(b.x)]) == gen, bar);
            __builtin_amdgcn_fence(__ATOMIC_ACQUIRE, "agent");
            asm volatile("s_waitcnt vmcnt(0)" ::: "memory");
        }
    }
    __syncthreads();
}

__global__ void __launch_bounds__(NTHREADS, 2) trunk_fwd(Args a) {
    extern __shared__ __attribute__((aligned(16))) unsigned char lds_raw[];
    cg::grid_group grid = cg::this_grid();
    LAS unsigned char* lds = (LAS unsigned char*)lds_raw;
    LAS float* rs = (LAS float*)(lds + LDS_RS);
    const int G = gridDim.x, w = blockIdx.x, NGW = G * NWAVES;
    if (a.ws == nullptr) grid.sync();
    const int wave_id = __builtin_amdgcn_readfirstlane((int)threadIdx.x >> 6);
#define MY_LANE() ((int)__builtin_amdgcn_mbcnt_hi(~0u, __builtin_amdgcn_mbcnt_lo(~0u, 0u)))
#define MY_TID() (wave_id * 64 + MY_LANE())
#define XBAR() xcd_barrier(xbar, wave_id == 0 && MY_LANE() == 0)
    volatile LAS unsigned* bst = (volatile LAS unsigned*)(lds + LDS_RS + 1024);
    if (MY_TID() < 4) bst[MY_TID()] = 0u;
    __syncthreads();
    const XcdBarrier xbar = xcd_barrier_post((unsigned*)a.ws + CW_BAR, bst, wave_id == 0 && MY_LANE() == 0);
#define WSP(T, off) ((T*)(ws + (off)))
#define PHASE_PTRS() unsigned long long wsi_ = (unsigned long long)a.ws; int tid = MY_TID(); asm volatile("" : "+s"(wsi_), "+v"(tid)); \
    unsigned char* ws = (unsigned char*)(__attribute__((address_space(1))) unsigned char*)wsi_; (void)ws;     \
    const int lane = tid & 63, wave = __builtin_amdgcn_readfirstlane(tid >> 6), gw = w * NWAVES + wave; (void)lane; (void)gw
#define LOAD_RSTD() do { if (tid < 256) { const f32x4* p = (const f32x4*)(WSP(float, WS_SSQ) + ((size_t)w * 256 + tid) * 16); float s = 0.f; \
        _Pragma("unroll") for (int j_ = 0; j_ < 4; ++j_) { const f32x4 v = p[j_]; s += (v[0] + v[1]) + (v[2] + v[3]); } \
        rs[tid] = 1.0f / sqrtf(s * (1.0f / D) + EPS); } __syncthreads(); } while (0)

#define BUILD_RSTD_TABLE(S_, nunits) do { LAS float* rt_ = (LAS float*)(lds + 131072); const float* sq_ = WSP(const float, WS_SSQ); \
        _Pragma("unroll 4") for (int i_ = 0; i_ < (nunits); i_ += 2) { pg8::Unit u_; (S_).next(i_ + (tid >> 8), u_); const f32x4* p_ = (const f32x4*)(sq_ + ((size_t)u_.pm * 256 + (tid & 255)) * 16); float s_ = 0.f; \
            _Pragma("unroll") for (int j_ = 0; j_ < 4; ++j_) { const f32x4 v_ = p_[j_]; s_ += (v_[0] + v_[1]) + (v_[2] + v_[3]); } \
            rt_[(i_ + (tid >> 8)) * 256 + (tid & 255)] = 1.0f / sqrtf(s_ * (1.0f / D) + EPS); } __syncthreads(); } while (0)
    { PHASE_PTRS(); prologue(a, lds, w, G, wave, lane); }
    XBAR();

#pragma nounroll
    for (int l = 0; l < DEPTH; ++l) {
        {   PHASE_PTRS(); const bf16* Win = WSP(const bf16, WS_W + W_IN) + (size_t)l * (W_LAYER / 2);
            bf16* um = WSP(bf16, WS_META + MB_UM); bf16* vTm = WSP(bf16, WS_META + MB_VTM);
            const float rm = meta_rstd(WSP(const float, WS_META + MB_SSQM), lane);
            meta_gemm(WSP(const bf16, WS_META + MB_HMB), Win, INW, D, w, G, wave, lane, lds, [&](int tile, int fr, int fq, f32x4 acc) {
                const int c0 = tile * 16 + 4 * fq; const f32x4 v = acc * rm;
                if (c0 < UW) { u32x2 o; o.x = pk2(v[0], v[1]); o.y = pk2(v[2], v[3]); *(u32x2*)(um + fr * UW + c0) = o; }
                else {
#pragma unroll
                    for (int e = 0; e < 4; ++e) vTm[(c0 - UW + e) * 16 + fr] = (bf16)(pk2(v[e], 0.f) & 0xffffu); } });
            LOAD_RSTD();
            { pg8::Gemm g{WSP(const bf16, WS_HB), Win, MT, UW, D}; pg8::StaticOrder S; S.init(MT, UW, G, w); BUILD_RSTD_TABLE(S, (MT / 256) * (UW / 256) / 256);
              pg8::EpiRowScale<0> E{WSP(bf16, WS_U), UW, (const LAS float*)(lds + 131072)};
              pg8::gemm_phase<pg8::EpiRowScale<0>, pg8::StaticOrder, true, true>(lds, g, S, E, tid); }
            { pg8::Gemm g{Win + (size_t)UW * D, WSP(const bf16, WS_HB), 512, MT, D}; pg8::OwnTileOrder S{w, 2, 1}; pg8::EpiColScale E{WSP(bf16, WS_VT), (size_t)MT, rs};
              pg8::gemm_phase<pg8::EpiColScale, pg8::OwnTileOrder, true, true>(lds, g, S, E, tid); }
        }
        XBAR();
        {   PHASE_PTRS();
            const int wv = (w & 7) * (G >> 3) + (w >> 3);
            mix_convpool(a, ws, l, wv, tid);
            const bool meta_live = l + 1 < DEPTH;
            if (w == G - 1 && meta_live) mix_convpool_meta(a, ws, l, tid);
            const int nit = (w == G - 1 && meta_live) ? 9 : 8;
            const int jb = wv & 7, Thi = 4 * jb + 4, Tl0 = (4 * jb - 2) > 0 ? (4 * jb - 2) : 0;
            u32x4 kx[AT_NT], vx[AT_NT];
            attn_stage_load(kx, vx, WSP(const bf16, WS_U), WSP(const bf16, WS_META + MB_UM), WSP(const bf16, WS_VT), WSP(const bf16, WS_META + MB_VTM), wv >> 3, 0, Tl0, tid);
#pragma nounroll
            for (int it = 0; it < nit; ++it) {
                int b = wv >> 3, h = it, P0 = NMETA + 256 * jb + 32 * wave, Tlo = Tl0;
                bf16* orow = WSP(bf16, WS_MIX) + ((size_t)b * SEQ + (P0 - NMETA) + (lane & 31)) * D + 512;
                if (it == 8) { b = 0; h = wave; P0 = 0; Tlo = 1; orow = (lane & 31) < NMETA ? WSP(bf16, WS_META + MB_MIXM) + (lane & 31) * D + 512 : nullptr; }
                asm volatile("" : "+s"(b), "+s"(h), "+s"(P0), "+s"(Tlo));
                __syncthreads();
                if (it < 8) attn_stage_store(lds, kx, vx, tid);
                __syncthreads();
                bf16x8 qf[4];
                { const bf16* qr = urow(WSP(const bf16, WS_U), WSP(const bf16, WS_META + MB_UM), b, P0 + (lane & 31)) + 1024 + h * 64 + 8 * (lane >> 5);
#pragma unroll
                  for (int d0 = 0; d0 < 4; ++d0) qf[d0] = *(const bf16x8*)(qr + 16 * d0); }
                attn_stage_load(kx, vx, WSP(const bf16, WS_U), WSP(const bf16, WS_META + MB_UM), WSP(const bf16, WS_VT), WSP(const bf16, WS_META + MB_VTM), wv >> 3, (it + 1 < 8) ? it + 1 : 7, Tl0, tid);
                sb_attn_wave(lds, Tlo, WSP(const bf16, WS_U), WSP(const bf16, WS_META + MB_UM), WSP(const bf16, WS_VT), WSP(const bf16, WS_META + MB_VTM), b, h, P0, qf, orow, lane);
            }
            __syncthreads();
        }
        XBAR();
        {   PHASE_PTRS(); const bf16* Wout = WSP(const bf16, WS_W + W_OUT) + (size_t)l * (W_LAYER / 2);
            float* hm = WSP(float, WS_META + MB_HM); bf16* hmb = WSP(bf16, WS_META + MB_HMB); float* ssqm = WSP(float, WS_META + MB_SSQM);
            meta_gemm(WSP(const bf16, WS_META + MB_MIXM), Wout, l + 1 < DEPTH ? D : 0  , D, w, G, wave, lane, lds, [&](int tile, int fr, int fq, f32x4 acc) {
                const int c0 = tile * 16 + 4 * fq; f32x4 v = *(f32x4*)(hm + fr * D + c0) + acc; *(f32x4*)(hm + fr * D + c0) = v;
                u32x2 o; o.x = pk2(v[0], v[1]); o.y = pk2(v[2], v[3]); *(u32x2*)(hmb + fr * D + c0) = o;
                float q = (v[0] * v[0] + v[1] * v[1]) + (v[2] * v[2] + v[3] * v[3]); q += __shfl_xor(q, 16); q += __shfl_xor(q, 32); if (fq == 0) ssqm[fr * 64 + tile] = q; });
            pg8::Gemm g{WSP(const bf16, WS_MIX), Wout, MT, D, D}; pg8::StaticOrder S; S.init(MT, D, G, w); pg8::EpiRes E{l == 0 ? a.x : nullptr, nullptr, WSP(bf16, WS_HB), WSP(float, WS_SSQ)};
            pg8::gemm_phase<pg8::EpiRes, pg8::StaticOrder, true, true>(lds, g, S, E, tid);
        }
        XBAR();
        {   PHASE_PTRS(); const bf16* Wup = WSP(const bf16, WS_W + W_UP) + (size_t)l * (W_LAYER / 2);
            bf16* hidm = WSP(bf16, WS_META + MB_HIDM);
            const float rm = meta_rstd(WSP(const float, WS_META + MB_SSQM), lane);
            meta_gemm(WSP(const bf16, WS_META + MB_HMB), Wup, l + 1 < DEPTH ? FF : 0, D, w, G, wave, lane, lds, [&](int tile, int fr, int fq, f32x4 acc) {
                const int c0 = tile * 16 + 4 * fq; f32x4 v = acc * rm;
#pragma unroll
                for (int e = 0; e < 4; ++e) { const float t = fmaxf(v[e], 0.f); v[e] = t * t; }
                u32x2 o; o.x = pk2(v[0], v[1]); o.y = pk2(v[2], v[3]); *(u32x2*)(hidm + fr * FF + c0) = o; });
            pg8::Gemm g{WSP(const bf16, WS_HB), Wup, MT, FF, D}; pg8::StaticOrder S; S.init(MT, FF, G, w); BUILD_RSTD_TABLE(S, (MT / 256) * (FF / 256) / 256);
            pg8::EpiRowScale<1> E{WSP(bf16, WS_HID), FF, (const LAS float*)(lds + 131072)};
            pg8::gemm_phase<pg8::EpiRowScale<1>, pg8::StaticOrder, true, true>(lds, g, S, E, tid);
        }
        XBAR();
        {   PHASE_PTRS(); const bf16* Wdn = WSP(const bf16, WS_W + W_DN) + (size_t)l * (W_LAYER / 2);
            float* hm = WSP(float, WS_META + MB_HM); bf16* hmb = WSP(bf16, WS_META + MB_HMB); float* ssqm = WSP(float, WS_META + MB_SSQM);
            meta_gemm(WSP(const bf16, WS_META + MB_HIDM), Wdn, l + 1 < DEPTH ? D : 0, FF, w, G, wave, lane, lds, [&](int tile, int fr, int fq, f32x4 acc) {
                const int c0 = tile * 16 + 4 * fq; f32x4 v = *(f32x4*)(hm + fr * D + c0) + acc; *(f32x4*)(hm + fr * D + c0) = v;
                u32x2 o; o.x = pk2(v[0], v[1]); o.y = pk2(v[2], v[3]); *(u32x2*)(hmb + fr * D + c0) = o;
                float q = (v[0] * v[0] + v[1] * v[1]) + (v[2] * v[2] + v[3] * v[3]); q += __shfl_xor(q, 16); q += __shfl_xor(q, 32); if (fq == 0) ssqm[fr * 64 + tile] = q; });
            pg8::Gemm g{WSP(const bf16, WS_HID), Wdn, MT, D, FF}; pg8::StaticOrder S; S.init(MT, D, G, w); pg8::EpiRes E{nullptr, nullptr, WSP(bf16, WS_HB), WSP(float, WS_SSQ)};
            pg8::gemm_phase<pg8::EpiRes, pg8::StaticOrder, true, true>(lds, g, S, E, tid);
        }
        XBAR();
    }
    {   PHASE_PTRS();
        __builtin_amdgcn_fence(__ATOMIC_ACQUIRE, "agent");
        __syncthreads();
        LOAD_RSTD();
        const f32x4* gf = (const f32x4*)a.g_final + lane; f32x4 gv[4];
#pragma unroll
        for (int jj = 0; jj < 4; ++jj) gv[jj] = gf[64 * jj];
        const bf16* hbf = WSP(const bf16, WS_HB);
        for (int i = wave * 4; i < 256; i += NWAVES * 4) { f32x4* orow = (f32x4*)(a.out + ((size_t)w * 256 + i) * D) + lane; const u32x2* hrow = (const u32x2*)(hbf + ((size_t)w * 256 + i) * D) + lane; u32x2 hv[4][4];
#pragma unroll
            for (int r = 0; r < 4; ++r)
#pragma unroll
                for (int jj = 0; jj < 4; ++jj) hv[r][jj] = hrow[r * 256 + 64 * jj];
#pragma unroll
            for (int r = 0; r < 4; ++r) { const float sc = rs[i + r];
#pragma unroll
                for (int jj = 0; jj < 4; ++jj) { const u32x2 t = hv[r][jj];
                    const f32x4 v = {__uint_as_float(t.x << 16), __uint_as_float(t.x & 0xffff0000u), __uint_as_float(t.y << 16), __uint_as_float(t.y & 0xffff0000u)};
                    __builtin_nontemporal_store(v * sc * gv[jj], orow + r * 256 + 64 * jj); } } }
    }
}

extern "C" void kernel_launch(void* const* d_in, const int* in_sizes, int n_in, void* d_out, int out_size, void* d_ws, size_t ws_size, hipStream_t stream) {
    static int grid = 0;
    if (grid == 0) {
        if (n_in != 12 || in_sizes[0] != MT * D || out_size != MT * D || ws_size < WS_END) { fprintf(stderr, "kernel_launch: unexpected shapes (n_in %d, in0 %d, out %d, ws %zu)\n", n_in, n_in > 0 ? in_sizes[0] : -1, out_size, ws_size); grid = -1; return; }
        int dev = 0, cus = 0, per_cu = 0;
        (void)hipGetDevice(&dev); (void)hipDeviceGetAttribute(&cus, hipDeviceAttributeMultiprocessorCount, dev);
        if (hipFuncSetAttribute((const void*)trunk_fwd, hipFuncAttributeMaxDynamicSharedMemorySize, LDS_BYTES) != hipSuccess) { fprintf(stderr, "kernel_launch: hipFuncSetAttribute failed\n"); grid = -1; return; }
        if (hipOccupancyMaxActiveBlocksPerMultiprocessor(&per_cu, (const void*)trunk_fwd, NTHREADS, LDS_BYTES) != hipSuccess || per_cu < 1) { fprintf(stderr, "kernel_launch: occupancy query says %d blocks/CU\n", per_cu); (void)hipGetLastError(); }
        if (cus != 256) fprintf(stderr, "kernel_launch: built for 256 CUs, device has %d\n", cus);
        grid = 256;
    }
    if (grid < 0) return;
    Args a{};
    a.x = (const float*)d_in[0]; a.meta = (const float*)d_in[1]; a.g_mix = (const float*)d_in[2]; a.w_in = (const float*)d_in[3]; a.w_conv = (const float*)d_in[4];
    a.w_pool = (const float*)d_in[5]; a.pool_scale = (const float*)d_in[6]; a.w_out = (const float*)d_in[7]; a.g_mlp = (const float*)d_in[8]; a.w_up = (const float*)d_in[9];
    a.w_down = (const float*)d_in[10]; a.g_final = (const float*)d_in[11]; a.out = (float*)d_out; a.ws = (unsigned char*)d_ws;
    if (hipMemsetAsync((char*)d_ws + WS_CTL, 0, CTL_ZERO_BYTES, stream) != hipSuccess) { fprintf(stderr, "kernel_launch: hipMemsetAsync of the barrier words failed\n"); return; }
    void* args[] = {&a};
    hipError_t e = hipLaunchCooperativeKernel((const void*)trunk_fwd, dim3(grid), dim3(NTHREADS), args, LDS_BYTES, stream);
    if (e != hipSuccess) fprintf(stderr, "kernel_launch: cooperative launch failed: %s\n", hipGetErrorString(e));
}
```

```cpp
#include <hip/hip_runtime.h>
#include <hip/hip_cooperative_groups.h>
#include <cstdio>
#include <cstdint>
namespace cg = cooperative_groups;

namespace pg8 {
#define PG8_LAS __attribute__((address_space(3)))
typedef unsigned short bf16_t;
typedef short bf16x8 __attribute__((ext_vector_type(8)));
typedef float f32x4 __attribute__((ext_vector_type(4)));
typedef unsigned u32x4 __attribute__((ext_vector_type(4)));
constexpr int BM = 256, BK = 64, HALF = 128, HTB = HALF * BK * 2, STAGE_BYTES = 8 * HTB;

__host__ __device__ __forceinline__ int lds_byte(int r, int c) { const int st = (r >> 4) * 2 + (c >> 5), rr = r & 15, cc = c & 31, ob = rr * 64 + cc * 2; return st * 1024 + (ob ^ (((ob >> 9) & 1) << 5)); }
__host__ __device__ __forceinline__ void stage_rc(int b, int& R, int& C) { const int st = b / 1024, sb = b % 1024, swz = sb ^ (((sb >> 9) & 1) << 5); R = (st >> 1) * 16 + swz / 64; C = (st & 1) * 32 + (swz % 64) / 2; }
__host__ __device__ __forceinline__ int perm32(int rho) { const int n = rho >> 4, i = rho & 15; return 8 * (i >> 2) + 4 * n + (i & 3); }

struct Unit { int pm, pn, idx; };
struct Gemm { const bf16_t* A; const bf16_t* Bt; int M, N, K; };

constexpr int NXCD = 8, WGM = 8;
struct StaticOrder {
    int nM, nN, nwg, G, c;
    __device__ __forceinline__ void init(int M, int N, int G_, int c_) { nM = M / BM; nN = N / BM; nwg = nM * nN; G = G_; c = c_; }
    __device__ __forceinline__ bool next(int i, Unit& u) const {
        const int L = i * G + c; if (L >= nwg) return false;
        int wgid = L; { const int q = nwg / NXCD, r = nwg % NXCD, xcd = wgid % NXCD, off = wgid / NXCD; wgid = (xcd < r ? xcd * (q + 1) : r * (q + 1) + (xcd - r) * q) + off; }
        const int nig = WGM * nN, gid = wgid / nig, fm = gid * WGM, gsz = (nM - fm) < WGM ? (nM - fm) : WGM;
        u.pm = fm + ((wgid % nig) % gsz); u.pn = (wgid % nig) / gsz; u.idx = i; return true;
    }
    __device__ __forceinline__ void a_ready(const Unit&) const {}
    __device__ __forceinline__ void done(const Unit&) const {}
};
struct OwnTileOrder {
    int own, n, swap;
    __device__ __forceinline__ bool next(int i, Unit& u) const { if (i >= n) return false; int o = own; asm volatile("" : "+s"(o)); u.pm = swap ? i : o; u.pn = swap ? o : i; u.idx = i; return true; }
    __device__ __forceinline__ void a_ready(const Unit&) const {}
    __device__ __forceinline__ void done(const Unit&) const {}
};

__device__ __forceinline__ unsigned cvt_pk_bf16(float lo, float hi) { unsigned r; asm volatile("v_cvt_pk_bf16_f32 %0, %1, %2" : "=v"(r) : "v"(lo), "v"(hi)); return r; }

template <int ACT> struct EpiRowScale {
    static constexpr bool PERM = true, AFTER_DRAIN = false;
    bf16_t* O; int ldc; const PG8_LAS float* rst;
    __device__ __forceinline__ void operator()(const f32x4 (&acc)[2][2][4][2], const Unit& u, int wr, int wc, int fr, int fq) const {
        asm volatile("" : "+v"(fr), "+v"(fq));
        const int rl0 = wr * 64 + fr, col0 = u.pn * BM + wc * 32 + 8 * fq;
#pragma unroll
        for (int ai = 0; ai < 2; ++ai)
#pragma unroll
            for (int m = 0; m < 4; ++m) { const int rl = rl0 + ai * HALF + m * 16; bf16_t* rowp = O + (size_t)(u.pm * BM + rl) * ldc + col0;
                const float s = rst[u.idx * BM + rl];
#pragma unroll
                for (int bj = 0; bj < 2; ++bj) { f32x4 v0 = acc[ai][bj][m][0] * s, v1 = acc[ai][bj][m][1] * s;
                    if (ACT == 1) {
#pragma unroll
                        for (int e = 0; e < 4; ++e) { const float a = fmaxf(v0[e], 0.f), b = fmaxf(v1[e], 0.f); v0[e] = a * a; v1[e] = b * b; } }
                    u32x4 w; w.x = cvt_pk_bf16(v0[0], v0[1]); w.y = cvt_pk_bf16(v0[2], v0[3]); w.z = cvt_pk_bf16(v1[0], v1[1]); w.w = cvt_pk_bf16(v1[2], v1[3]);
                    __builtin_nontemporal_store(w, (u32x4*)(rowp + bj * HALF)); } }
    }
};
struct EpiColScale {
    static constexpr bool PERM = true, AFTER_DRAIN = false;
    bf16_t* O; size_t ldc; const PG8_LAS float* rs;
    __device__ __forceinline__ void operator()(const f32x4 (&acc)[2][2][4][2], const Unit& u, int wr, int wc, int fr, int fq) const {
        asm volatile("" : "+v"(fr), "+v"(fq));
        const int rl0 = wr * 64 + fr, cl0 = wc * 32 + 8 * fq;
        f32x4 sv[2][2];
#pragma unroll
        for (int bj = 0; bj < 2; ++bj)
#pragma unroll
            for (int n = 0; n < 2; ++n) sv[bj][n] = *(const PG8_LAS f32x4*)(rs + cl0 + bj * HALF + 4 * n);
#pragma unroll
        for (int ai = 0; ai < 2; ++ai)
#pragma unroll
            for (int m = 0; m < 4; ++m) { const int rl = rl0 + ai * HALF + m * 16; bf16_t* rowp = O + (size_t)(u.pm * BM + rl) * ldc + (size_t)u.pn * BM + cl0;
#pragma unroll
                for (int bj = 0; bj < 2; ++bj) { const f32x4 v0 = acc[ai][bj][m][0] * sv[bj][0], v1 = acc[ai][bj][m][1] * sv[bj][1];
                    u32x4 w; w.x = cvt_pk_bf16(v0[0], v0[1]); w.y = cvt_pk_bf16(v0[2], v0[3]); w.z = cvt_pk_bf16(v1[0], v1[1]); w.w = cvt_pk_bf16(v1[2], v1[3]);
                    *(u32x4*)(rowp + bj * HALF) = w; } }
    }
};
struct EpiRes {
    static constexpr bool PERM = true, AFTER_DRAIN = false;
    const float* res32; float* out32; bf16_t* hb; float* ssq;
    __device__ __forceinline__ void finish_half(const f32x4 (&acc)[2][2][4][2], const f32x4 (&r)[4][2][2], const Unit& u, int ai, int rl0, int col0, int wc, int fq) const {
#pragma unroll
        for (int m = 0; m < 4; ++m) { const size_t row = (size_t)(u.pm * BM + rl0 + ai * HALF + m * 16); const size_t off = row * 1024 + col0; float q = 0.f;
#pragma unroll
            for (int bj = 0; bj < 2; ++bj) {
                const f32x4 v0 = acc[ai][bj][m][0] + r[m][bj][0], v1 = acc[ai][bj][m][1] + r[m][bj][1];
                if (out32) { *(f32x4*)(out32 + off + bj * HALF) = v0; *(f32x4*)(out32 + off + bj * HALF + 4) = v1; }
                q += (v0[0] * v0[0] + v0[1] * v0[1]) + (v0[2] * v0[2] + v0[3] * v0[3]) + (v1[0] * v1[0] + v1[1] * v1[1]) + (v1[2] * v1[2] + v1[3] * v1[3]);
                u32x4 w; w.x = cvt_pk_bf16(v0[0], v0[1]); w.y = cvt_pk_bf16(v0[2], v0[3]); w.z = cvt_pk_bf16(v1[0], v1[1]); w.w = cvt_pk_bf16(v1[2], v1[3]);
                *(u32x4*)(hb + off + bj * HALF) = w; }
            q += __shfl_xor(q, 16); q += __shfl_xor(q, 32);
            if (fq == 0) ssq[row * 16 + u.pn * 4 + wc] = q; }
    }
    __device__ __forceinline__ void operator()(const f32x4 (&acc)[2][2][4][2], const Unit& u, int wr, int wc, int fr, int fq) const {
        asm volatile("" : "+v"(fr), "+v"(fq));
        const int rl0 = wr * 64 + fr, col0 = u.pn * BM + wc * 32 + 8 * fq;
        if (res32) {
#pragma unroll
            for (int ai = 0; ai < 2; ++ai) { f32x4 r[4][2][2];
#pragma unroll
                for (int m = 0; m < 4; ++m)
#pragma unroll
                    for (int bj = 0; bj < 2; ++bj) { const size_t off = (size_t)(u.pm * BM + rl0 + ai * HALF + m * 16) * 1024 + col0 + bj * HALF;
                        r[m][bj][0] = *(const f32x4*)(res32 + off); r[m][bj][1] = *(const f32x4*)(res32 + off + 4); }
                finish_half(acc, r, u, ai, rl0, col0, wc, fq); }
        } else {
            u32x4 hv[2][4][2];
#pragma unroll
            for (int ai = 0; ai < 2; ++ai)
#pragma unroll
                for (int m = 0; m < 4; ++m)
#pragma unroll
                    for (int bj = 0; bj < 2; ++bj) hv[ai][m][bj] = *(const u32x4*)(hb + (size_t)(u.pm * BM + rl0 + ai * HALF + m * 16) * 1024 + col0 + bj * HALF);
            asm volatile("" ::: "memory");
#pragma unroll
            for (int ai = 0; ai < 2; ++ai) { f32x4 r[4][2][2];
#pragma unroll
                for (int m = 0; m < 4; ++m)
#pragma unroll
                    for (int bj = 0; bj < 2; ++bj) { const u32x4 t = hv[ai][m][bj];
                        r[m][bj][0] = (f32x4){__uint_as_float(t.x << 16), __uint_as_float(t.x & 0xffff0000u), __uint_as_float(t.y << 16), __uint_as_float(t.y & 0xffff0000u)};
                        r[m][bj][1] = (f32x4){__uint_as_float(t.z << 16), __uint_as_float(t.z & 0xffff0000u), __uint_as_float(t.w << 16), __uint_as_float(t.w & 0xffff0000u)}; }
                finish_half(acc, r, u, ai, rl0, col0, wc, fq); }
        }
    }
};

template <class Epi, class Sched, bool ALIGN_EPI = false, bool SP2 = false>
__device__ __forceinline__ void gemm_phase(PG8_LAS unsigned char* lds, const Gemm g, const Sched& S, const Epi& E, int tid_in) {
    int tid_ = tid_in; asm volatile("" : "+v"(tid_));
    const int tid = tid_, wid = __builtin_amdgcn_readfirstlane(tid >> 6), lane = tid & 63, wr = wid >> 2, wc = wid & 3, fr = lane & 15, fq = lane >> 4;
    const int K = g.K, nt = K / BK;
    unsigned voffA[2], voffB[2];
#pragma unroll
    for (int i = 0; i < 2; ++i) { int R, C; stage_rc(tid * 16 + i * 8192, R, C); const int Rb = Epi::PERM ? ((R & ~31) + perm32(R & 31)) : R;
        voffA[i] = (unsigned)(R * K + C) * 2u; voffB[i] = (unsigned)(Rb * K + C) * 2u; }
    const size_t kstep = (size_t)(BK * 2);
    const size_t hstep = (size_t)HALF * K * 2;
    const size_t tstep = 2 * hstep;
    const unsigned ldsw = (unsigned)wid * 1024u;
    const int aoff = lds_byte(wr * 64 + fr, fq * 8), boff = lds_byte(wc * 32 + fr, fq * 8);
#define PG8_SA(b, h) (((b) * 2 + (h)) * HTB)
#define PG8_SB(b, h) ((4 + (b) * 2 + (h)) * HTB)
#define PG8_STAGE(bufoff, gbase, voff) do { _Pragma("unroll") for (int _i = 0; _i < 2; ++_i) \
        __builtin_amdgcn_global_load_lds((const unsigned*)((const char*)(gbase) + (voff)[_i]), (PG8_LAS unsigned*)(lds + (bufoff) + ldsw + _i * 8192), 16, 0, 0); } while (0)
#define PG8_LDA(dst, b, h) do { _Pragma("unroll") for (int m = 0; m < 4; ++m) _Pragma("unroll") for (int k = 0; k < 2; ++k) dst[m][k] = *(const PG8_LAS bf16x8*)(lds + PG8_SA(b, h) + aoff + m * 2048 + k * 1024); } while (0)
#define PG8_LDB(dst, b, h) do { _Pragma("unroll") for (int n = 0; n < 2; ++n) _Pragma("unroll") for (int k = 0; k < 2; ++k) dst[n][k] = *(const PG8_LAS bf16x8*)(lds + PG8_SB(b, h) + boff + n * 2048 + k * 1024); } while (0)
#define PG8_MMA(ai, bj, At, Bt) do { __builtin_amdgcn_s_setprio(1); _Pragma("unroll") for (int k = 0; k < 2; ++k) _Pragma("unroll") for (int m = 0; m < 4; ++m) _Pragma("unroll") for (int n = 0; n < 2; ++n) \
        acc[ai][bj][m][n] = __builtin_amdgcn_mfma_f32_16x16x32_bf16(Bt[n][k], At[m][k], acc[ai][bj][m][n], 0, 0, 0); __builtin_amdgcn_s_setprio(0); } while (0)
#define PG8_WAIT_V(n) asm volatile("s_waitcnt vmcnt(" #n ")" ::: "memory")
#define PG8_WAIT_L(n) asm volatile("s_waitcnt lgkmcnt(" #n ")" ::: "memory")
#define PG8_BAR __builtin_amdgcn_s_barrier()
#define PG8_SCHED __builtin_amdgcn_sched_barrier(0)
    Unit cur, nxt; int ui = 0;
    if (!S.next(0, cur)) return;
    f32x4 acc[2][2][4][2];
#pragma unroll
    for (int a = 0; a < 2; ++a)
#pragma unroll
        for (int b = 0; b < 2; ++b)
#pragma unroll
            for (int m = 0; m < 4; ++m)
#pragma unroll
                for (int n = 0; n < 2; ++n) acc[a][b][m][n] = (f32x4){0.f, 0.f, 0.f, 0.f};
    bf16x8 At[4][2], B0[2][2], B1[2][2];
    const char* cA = (const char*)g.A + (size_t)cur.pm * tstep; const char* cB = (const char*)g.Bt + (size_t)cur.pn * tstep;
    S.a_ready(cur);
    if constexpr (SP2) {
        PG8_STAGE(PG8_SB(0, 0), cB, voffB); PG8_STAGE(PG8_SB(0, 1), cB + hstep, voffB); PG8_STAGE(PG8_SA(0, 0), cA, voffA); PG8_STAGE(PG8_SA(0, 1), cA + hstep, voffA);
        if (wr == 1) PG8_BAR;
        PG8_WAIT_V(2); PG8_BAR;
        PG8_STAGE(PG8_SB(1, 0), cB + kstep, voffB); PG8_STAGE(PG8_SA(1, 0), cA + kstep, voffA); PG8_STAGE(PG8_SB(1, 1), cB + hstep + kstep, voffB);
        PG8_WAIT_V(6); PG8_BAR;
    } else {
        PG8_STAGE(PG8_SB(0, 0), cB, voffB); PG8_STAGE(PG8_SA(0, 0), cA, voffA); PG8_STAGE(PG8_SB(0, 1), cB + hstep, voffB); PG8_STAGE(PG8_SA(0, 1), cA + hstep, voffA);
        if (wr == 1) PG8_BAR;
        PG8_WAIT_V(4); PG8_BAR;
        PG8_STAGE(PG8_SB(1, 0), cB + kstep, voffB); PG8_STAGE(PG8_SA(1, 0), cA + kstep, voffA); PG8_STAGE(PG8_SB(1, 1), cB + hstep + kstep, voffB);
        PG8_WAIT_V(6); PG8_BAR;
    }
    for (;;) {
        const bool has_next = S.next(ui + 1, nxt);
        const char* nA = has_next ? (const char*)g.A + (size_t)nxt.pm * tstep : cA; const char* nB = has_next ? (const char*)g.Bt + (size_t)nxt.pn * tstep : cB;
        for (int t = 0; t < nt; t += 2) {
            const bool last = (t == nt - 2);
            const char* a1 = cA + (size_t)(t + 1) * kstep;
            const char* a2 = last ? nA : cA + (size_t)(t + 2) * kstep; const char* b2 = last ? nB : cB + (size_t)(t + 2) * kstep;
            const char* a3 = a2 + kstep; const char* b3 = b2 + kstep;
            if (last && has_next) S.a_ready(nxt);
            if constexpr (SP2) {
            PG8_LDB(B0, 0, 0); PG8_LDB(B1, 0, 1); PG8_SCHED; PG8_LDA(At, 0, 0); PG8_STAGE(PG8_SA(1, 1), a1 + hstep, voffA);
            PG8_WAIT_V(8); PG8_WAIT_L(0); PG8_BAR; PG8_MMA(0, 0, At, B0); PG8_MMA(0, 1, At, B1); PG8_BAR; PG8_SCHED;
            PG8_LDA(At, 0, 1); PG8_STAGE(PG8_SB(0, 0), b2, voffB); PG8_STAGE(PG8_SB(0, 1), b2 + hstep, voffB); PG8_STAGE(PG8_SA(0, 0), a2, voffA);
            PG8_WAIT_V(8); PG8_WAIT_L(0); PG8_BAR; PG8_MMA(1, 0, At, B0); PG8_MMA(1, 1, At, B1); PG8_BAR; PG8_SCHED;
            PG8_LDB(B0, 1, 0); PG8_LDB(B1, 1, 1); PG8_SCHED; PG8_LDA(At, 1, 0); PG8_STAGE(PG8_SA(0, 1), a2 + hstep, voffA);
            PG8_WAIT_V(8); PG8_WAIT_L(0); PG8_BAR; PG8_MMA(0, 0, At, B0); PG8_MMA(0, 1, At, B1); PG8_BAR; PG8_SCHED;
            PG8_LDA(At, 1, 1); PG8_STAGE(PG8_SB(1, 0), b3, voffB); PG8_STAGE(PG8_SB(1, 1), b3 + hstep, voffB); PG8_STAGE(PG8_SA(1, 0), a3, voffA);
            PG8_WAIT_V(8); PG8_WAIT_L(0); PG8_BAR; PG8_MMA(1, 0, At, B0); PG8_MMA(1, 1, At, B1); PG8_BAR; PG8_SCHED;
            } else {
            PG8_LDB(B0, 0, 0); PG8_SCHED; PG8_LDA(At, 0, 0); PG8_STAGE(PG8_SA(1, 1), a1 + hstep, voffA);
            PG8_WAIT_L(8); PG8_BAR; PG8_WAIT_L(0); PG8_MMA(0, 0, At, B0); PG8_BAR; PG8_SCHED;
            PG8_LDB(B1, 0, 1); PG8_STAGE(PG8_SB(0, 0), b2, voffB);
            PG8_BAR; PG8_WAIT_L(0); PG8_MMA(0, 1, At, B1); PG8_BAR;
            PG8_LDA(At, 0, 1); PG8_STAGE(PG8_SA(0, 0), a2, voffA);
            PG8_BAR; PG8_WAIT_L(0); PG8_MMA(1, 0, At, B0); PG8_BAR; PG8_SCHED;
            PG8_STAGE(PG8_SB(0, 1), b2 + hstep, voffB);
            PG8_WAIT_V(6); PG8_BAR; PG8_MMA(1, 1, At, B1); PG8_BAR;
            PG8_LDB(B0, 1, 0); PG8_SCHED; PG8_LDA(At, 1, 0); PG8_STAGE(PG8_SA(0, 1), a2 + hstep, voffA);
            PG8_WAIT_L(8); PG8_BAR; PG8_WAIT_L(0); PG8_MMA(0, 0, At, B0); PG8_BAR; PG8_SCHED;
            PG8_LDB(B1, 1, 1); PG8_STAGE(PG8_SB(1, 0), b3, voffB);
            PG8_BAR; PG8_WAIT_L(0); PG8_MMA(0, 1, At, B1); PG8_BAR;
            PG8_LDA(At, 1, 1); PG8_STAGE(PG8_SA(1, 0), a3, voffA);
            PG8_BAR; PG8_WAIT_L(0); PG8_MMA(1, 0, At, B0); PG8_BAR; PG8_SCHED;
            PG8_STAGE(PG8_SB(1, 1), b3 + hstep, voffB);
            PG8_WAIT_V(6); PG8_BAR; PG8_MMA(1, 1, At, B1); PG8_BAR;
            }
        }
        if constexpr (ALIGN_EPI) { if (wr == 0) PG8_BAR; }
        if constexpr (!Epi::AFTER_DRAIN) { E(acc, cur, wr, wc, fr, fq); S.done(cur); }
        if (!has_next) break;
#pragma unroll
        for (int a = 0; a < 2; ++a)
#pragma unroll
            for (int b = 0; b < 2; ++b)
#pragma unroll
                for (int m = 0; m < 4; ++m)
#pragma unroll
                    for (int n = 0; n < 2; ++n) acc[a][b][m][n] = (f32x4){0.f, 0.f, 0.f, 0.f};
        cur = nxt; cA = nA; cB = nB; ++ui;
        if constexpr (ALIGN_EPI) { if (wr == 1) PG8_BAR; }
    }
    PG8_WAIT_V(0);
    if constexpr (!ALIGN_EPI) { if (wr == 0) PG8_BAR; }
    PG8_BAR;
#undef PG8_SA
#undef PG8_SB
#undef PG8_STAGE
#undef PG8_LDA
#undef PG8_LDB
#undef PG8_MMA
#undef PG8_WAIT_V
#undef PG8_WAIT_L
#undef PG8_BAR
#undef PG8_SCHED
}
}

constexpr int NB = 32, SEQ = 2048, D = 1024, NMETA = 16, DEPTH = 2;
constexpr int MT = NB * SEQ;
constexpr int INW = 2560, UW = 2048, FF = 4096;
constexpr int LPOS = NMETA + SEQ;
constexpr float EPS = 1e-6f;
constexpr int NWAVES = 8, NTHREADS = 512;

typedef unsigned short bf16;
typedef short bf16x8 __attribute__((ext_vector_type(8)));
typedef float f32x4 __attribute__((ext_vector_type(4)));
typedef float f32x16 __attribute__((ext_vector_type(16)));
typedef unsigned u32x4 __attribute__((ext_vector_type(4)));
typedef unsigned u32x2 __attribute__((ext_vector_type(2)));
#define LAS __attribute__((address_space(3)))

constexpr size_t MiB = 1u << 20;
constexpr size_t WS_CTL = 0, CTL_ZERO_BYTES = 65536; constexpr int CW_BAR = 1024;
constexpr size_t WS_W = 1 * MiB;
constexpr size_t W_LAYER = 23 * MiB, W_IN = 0, W_OUT = 5 * MiB, W_UP = 7 * MiB, W_DN = 15 * MiB;
constexpr size_t WS_META = 47 * MiB;
constexpr size_t MB_HM = 0, MB_HMB = 64 * 1024, MB_UM = 96 * 1024, MB_VTM = 176 * 1024, MB_MIXM = 192 * 1024, MB_HIDM = 224 * 1024, MB_SSQM = 352 * 1024;
constexpr size_t WS_SSQ = 48 * MiB;
constexpr size_t WS_HB = 52 * MiB;
constexpr size_t WS_U = 180 * MiB;
constexpr size_t WS_VT = 436 * MiB;
constexpr size_t WS_MIX = 500 * MiB;
constexpr size_t WS_HID = 180 * MiB;
constexpr size_t WS_END = 692 * MiB;

constexpr int LDS_STAGE = 147456, LDS_RS = LDS_STAGE, LDS_BYTES = LDS_STAGE + 2048;

__device__ __forceinline__ float bf2f(unsigned short h) { return __uint_as_float((unsigned)h << 16); }
__device__ __forceinline__ unsigned pk2(float lo, float hi) { return pg8::cvt_pk_bf16(lo, hi); }
__device__ __forceinline__ float wave_sum(float v) {
#pragma unroll
    for (int o = 1; o < 64; o <<= 1) v += __shfl_xor(v, o);
    return v;
}

struct Args {
    const float *x, *meta, *g_mix, *w_in, *w_conv, *w_pool, *pool_scale, *w_out, *g_mlp, *w_up, *w_down, *g_final;
    float* out; unsigned char* ws;
};

__device__ __forceinline__ void tile_writeout(LAS float* scr, bf16* WT, int K, int row0, int k0, int lane) {
    const int c = lane & 7;
#pragma unroll
    for (int j = 0; j < 4; ++j) { const int n = (lane >> 3) + 8 * j; const LAS float* s = scr + (8 * c) * 33 + n;
        u32x4 o; o.x = pk2(s[0 * 33], s[1 * 33]); o.y = pk2(s[2 * 33], s[3 * 33]); o.z = pk2(s[4 * 33], s[5 * 33]); o.w = pk2(s[6 * 33], s[7 * 33]);
        *(u32x4*)(WT + (size_t)(row0 + n) * K + k0 + 8 * c) = o; }
    asm volatile("s_waitcnt lgkmcnt(0)" ::: "memory");
}
#define GAS __attribute__((address_space(1)))
__device__ __forceinline__ void transpose_item(const float* W_, int K, int N, bf16* WT, const float* gk_, float cs, LAS float* scr, int kb, int nb, int lane) {
    const int k0 = 64 * kb, n0 = 32 * nb; const GAS float* W = (const GAS float*)W_; const GAS float* gk = (const GAS float*)gk_;
    float wv[32];
#pragma unroll
    for (int i = 0; i < 32; ++i) wv[i] = W[(size_t)(k0 + 2 * i + (lane >> 5)) * N + n0 + (lane & 31)];
#pragma unroll
    for (int i = 0; i < 32; ++i) { const int kk = 2 * i + (lane >> 5); const float gv = gk_ ? gk[k0 + kk] : 1.f;
        scr[kk * 33 + (lane & 31)] = wv[i] * gv * cs; }
    asm volatile("s_waitcnt lgkmcnt(0)" ::: "memory");
    tile_writeout(scr, WT, K, n0, k0, lane);
}
__device__ __forceinline__ void poolfold_item(const float* Win_, const float* wp_, const float* scale, const float* gk, bf16* WT, LAS float* scr, int kb, int nb, int lane) {
    const int k0 = 64 * kb, g = nb >> 1, d = (nb & 1) * 32 + (lane & 31), kh = lane >> 5; const GAS float* Win = (const GAS float*)Win_; const GAS float* wp = (const GAS float*)wp_;
#pragma unroll 32
    for (int i = 0; i < 64; ++i) scr[i * 64 + lane] = Win[(size_t)(k0 + i) * INW + 768 + 64 * g + lane];
    const GAS float* wpc = wp + (size_t)g * 4096 + d;
    float wreg[64];
#pragma unroll
    for (int c = 0; c < 64; ++c) wreg[c] = wpc[c * 64];
    asm volatile("s_waitcnt lgkmcnt(0)" ::: "memory");
    float accv[32];
#pragma unroll
    for (int kk = 0; kk < 32; ++kk) accv[kk] = 0.f;
#pragma unroll
    for (int c = 0; c < 64; c += 4) {
        const float w0 = wreg[c], w1 = wreg[c + 1], w2 = wreg[c + 2], w3 = wreg[c + 3];
#pragma unroll
        for (int kk = 0; kk < 32; ++kk) { const f32x4 a = *(const LAS f32x4*)(scr + (2 * kk + kh) * 64 + c); accv[kk] += (a[0] * w0 + a[1] * w1) + (a[2] * w2 + a[3] * w3); }
    }
    const float sc = scale[64 * g + d];
    asm volatile("s_waitcnt lgkmcnt(0)" ::: "memory");
#pragma unroll
    for (int kk = 0; kk < 32; ++kk) { const int k = 2 * kk + kh; scr[k * 33 + (lane & 31)] = accv[kk] * sc * gk[k0 + k]; }
    asm volatile("s_waitcnt lgkmcnt(0)" ::: "memory");
    tile_writeout(scr, WT, D, 768 + 32 * nb, k0, lane);
}

constexpr float QSCALE = 0.125f * 1.4426950408889634f;

__device__ __forceinline__ void prologue(const Args& a, LAS unsigned char* lds, int w, int G, int wave, int lane) {
    LAS float* scr = (LAS float*)(lds + wave * 16384);
    const int gw = w * NWAVES + wave, NGW = G * NWAVES;
    constexpr int I_IN = 16 * 80, I_OUT = 16 * 32, I_UP = 16 * 128, I_DN = 64 * 32, I_L = I_IN + I_OUT + I_UP + I_DN;
    for (int it = gw; it < DEPTH * I_L; it += NGW) {
        const int l = it / I_L; int r = it % I_L;
        unsigned char* wl = a.ws + WS_W + (size_t)l * W_LAYER;
        if (r < I_IN) { const int kb = r / 80, nb = r % 80; const float* Win = a.w_in + (size_t)l * D * INW; const float* gk = a.g_mix + l * D;
            if (nb >= 24 && nb < 32) poolfold_item(Win, a.w_pool + (size_t)l * 4 * 4096, a.pool_scale + l * 256, gk, (bf16*)(wl + W_IN), scr, kb, nb - 24, lane);
            else transpose_item(Win, D, INW, (bf16*)(wl + W_IN), gk, (nb >= 32 && nb < 48) ? QSCALE : 1.f, scr, kb, nb, lane);
            continue; }
        r -= I_IN;
        if (r < I_OUT) { transpose_item(a.w_out + (size_t)l * D * D, D, D, (bf16*)(wl + W_OUT), nullptr, 1.f, scr, r / 32, r % 32, lane); continue; }
        r -= I_OUT;
        if (r < I_UP) { transpose_item(a.w_up + (size_t)l * D * FF, D, FF, (bf16*)(wl + W_UP), a.g_mlp + l * D, 1.f, scr, r / 128, r % 128, lane); continue; }
        r -= I_UP;
        transpose_item(a.w_down + (size_t)l * FF * D, FF, D, (bf16*)(wl + W_DN), nullptr, 1.f, scr, r / 32, r % 32, lane);
    }
    bf16* hb = (bf16*)(a.ws + WS_HB); float* ssq = (float*)(a.ws + WS_SSQ);
    for (int i = wave * 4; i < 256; i += NWAVES * 4) { const size_t row = (size_t)w * 256 + i;
        const f32x4* xr = (const f32x4*)(a.x + row * D) + lane; f32x4 v[4][4]; float sq[4];
#pragma unroll
        for (int r = 0; r < 4; ++r)
#pragma unroll
            for (int j = 0; j < 4; ++j) v[r][j] = __builtin_nontemporal_load(xr + r * 256 + 64 * j);
#pragma unroll
        for (int r = 0; r < 4; ++r) { float s = 0.f;
#pragma unroll
            for (int j = 0; j < 4; ++j) s += (v[r][j][0] * v[r][j][0] + v[r][j][1] * v[r][j][1]) + (v[r][j][2] * v[r][j][2] + v[r][j][3] * v[r][j][3]);
            sq[r] = wave_sum(s); }
#pragma unroll
        for (int r = 0; r < 4; ++r) { u32x2* o8 = (u32x2*)(hb + (row + r) * D) + lane;
#pragma unroll
            for (int j = 0; j < 4; ++j) { u32x2 o; o.x = pk2(v[r][j][0], v[r][j][1]); o.y = pk2(v[r][j][2], v[r][j][3]); o8[64 * j] = o; }
            if (lane < 16) ssq[(row + r) * 16 + lane] = lane == 0 ? sq[r] : 0.f; } }
    if (w == 0) { unsigned char* mb = a.ws + WS_META; float* hm = (float*)(mb + MB_HM); bf16* hmb = (bf16*)(mb + MB_HMB); float* ssqm = (float*)(mb + MB_SSQM);
        for (int row = wave; row < NMETA; row += NWAVES) { const f32x4* xr = (const f32x4*)(a.meta + row * D) + lane; float s = 0.f;
#pragma unroll
            for (int j = 0; j < 4; ++j) { const f32x4 v = xr[64 * j]; s += (v[0] * v[0] + v[1] * v[1]) + (v[2] * v[2] + v[3] * v[3]);
                ((f32x4*)(hm + row * D))[lane + 64 * j] = v; u32x2 o; o.x = pk2(v[0], v[1]); o.y = pk2(v[2], v[3]); ((u32x2*)(hmb + row * D))[lane + 64 * j] = o; }
            s = wave_sum(s); ssqm[row * 64 + lane] = lane == 0 ? s : 0.f; } }
}

template <class F> __device__ __forceinline__ void meta_gemm(const bf16* A, const bf16* Bt, int N, int K, int w, int G, int wave, int lane, LAS unsigned char* lds, F epi) {
    const int fr = lane & 15, fq = lane >> 4, kc = K / 8;
    for (int tile = w; tile < N / 16; tile += G) {
        const bf16x8* ap = (const bf16x8*)(A + (size_t)fr * K + wave * kc + fq * 8); const bf16x8* bp = (const bf16x8*)(Bt + (size_t)(tile * 16 + fr) * K + wave * kc + fq * 8);
        f32x4 acc0 = {0.f, 0.f, 0.f, 0.f}, acc1 = {0.f, 0.f, 0.f, 0.f};
        for (int kk = 0; kk < kc / 32; kk += 4) {
            const bf16x8 a0 = ap[(kk + 0) * 4], a1 = ap[(kk + 1) * 4], a2 = ap[(kk + 2) * 4], a3 = ap[(kk + 3) * 4];
            const bf16x8 b0 = bp[(kk + 0) * 4], b1 = bp[(kk + 1) * 4], b2 = bp[(kk + 2) * 4], b3 = bp[(kk + 3) * 4];
            acc0 = __builtin_amdgcn_mfma_f32_16x16x32_bf16(b0, a0, acc0, 0, 0, 0); acc1 = __builtin_amdgcn_mfma_f32_16x16x32_bf16(b1, a1, acc1, 0, 0, 0);
            acc0 = __builtin_amdgcn_mfma_f32_16x16x32_bf16(b2, a2, acc0, 0, 0, 0); acc1 = __builtin_amdgcn_mfma_f32_16x16x32_bf16(b3, a3, acc1, 0, 0, 0);
        }
        LAS f32x4* red = (LAS f32x4*)lds;
        red[wave * 64 + lane] = acc0 + acc1;
        __syncthreads();
        if (wave == 0) { f32x4 t = red[lane];
#pragma unroll
            for (int j = 1; j < 8; ++j) t += red[j * 64 + lane];
            epi(tile, fr, fq, t); }
        __syncthreads();
    }
}
__device__ __forceinline__ float meta_rstd(const float* ssqm, int lane) {
    const int fr = lane & 15, fq = lane >> 4; const f32x4* p = (const f32x4*)(ssqm + fr * 64 + fq * 16); float s = 0.f;
#pragma unroll
    for (int j = 0; j < 4; ++j) { const f32x4 v = p[j]; s += (v[0] + v[1]) + (v[2] + v[3]); }
    s += __shfl_xor(s, 16); s += __shfl_xor(s, 32);
    return 1.0f / sqrtf(s * (1.0f / D) + EPS);
}

__device__ __forceinline__ const bf16* urow(const bf16* u, const bf16* um, int b, int p) { return p < NMETA ? um + (size_t)p * UW : u + ((size_t)b * SEQ + (p - NMETA)) * UW; }
__device__ __forceinline__ void ld8(const bf16* p, float (&v)[8]) { const u32x4 r = *(const u32x4*)p;
    v[0] = __uint_as_float(r.x << 16); v[1] = __uint_as_float(r.x & 0xffff0000u); v[2] = __uint_as_float(r.y << 16); v[3] = __uint_as_float(r.y & 0xffff0000u);
    v[4] = __uint_as_float(r.z << 16); v[5] = __uint_as_float(r.z & 0xffff0000u); v[6] = __uint_as_float(r.w << 16); v[7] = __uint_as_float(r.w & 0xffff0000u); }
__device__ __forceinline__ void st8(bf16* p, const float (&v)[8]) { u32x4 o; o.x = pk2(v[0], v[1]); o.y = pk2(v[2], v[3]); o.z = pk2(v[4], v[5]); o.w = pk2(v[6], v[7]); *(u32x4*)p = o; }

__device__ __forceinline__ void up8(const u32x4 r, float (&v)[8]) {
    v[0] = __uint_as_float(r.x << 16); v[1] = __uint_as_float(r.x & 0xffff0000u); v[2] = __uint_as_float(r.y << 16); v[3] = __uint_as_float(r.y & 0xffff0000u);
    v[4] = __uint_as_float(r.z << 16); v[5] = __uint_as_float(r.z & 0xffff0000u); v[6] = __uint_as_float(r.w << 16); v[7] = __uint_as_float(r.w & 0xffff0000u); }
__device__ __forceinline__ void mix_convpool(const Args& a, unsigned char* ws, int l, int w, int tid) {
    const bf16* u = (const bf16*)(ws + WS_U); const bf16* um = (const bf16*)(ws + WS_META + MB_UM); bf16* mix = (bf16*)(ws + WS_MIX);
    const int b = w >> 3, j = w & 7, ch = (tid & 31) * 8, rg = tid >> 5, p0 = NMETA + 256 * j + rg * 16;
    const float* wc = a.w_conv + (size_t)l * 3 * 256 + ch; float w0[8], w1[8], w2[8], g2[8], g1[8], s[8], t0[8], t1[8];
    const int W = 2 << (ch >> 6); const float invW = 1.0f / (float)W;
#pragma unroll
    for (int e = 0; e < 8; ++e) { w0[e] = wc[e]; w1[e] = wc[256 + e]; w2[e] = wc[512 + e]; s[e] = 0.f; }
    {
        u32x4 hc[4], hz[15];
        { const bf16* r = urow(u, um, b, p0 - 2); hc[0] = *(const u32x4*)(r + 256 + ch); hc[1] = *(const u32x4*)(r + 512 + ch);
          r = urow(u, um, b, p0 - 1); hc[2] = *(const u32x4*)(r + 256 + ch); hc[3] = *(const u32x4*)(r + 512 + ch); }
#pragma unroll
        for (int k = 1; k < 16; ++k) hz[k - 1] = *(const u32x4*)(urow(u, um, b, p0 - (k < W ? k : 1)) + 768 + ch);
        up8(hc[0], t0); up8(hc[1], t1);
#pragma unroll
        for (int e = 0; e < 8; ++e) g2[e] = t0[e] * t1[e];
        up8(hc[2], t0); up8(hc[3], t1);
#pragma unroll
        for (int e = 0; e < 8; ++e) g1[e] = t0[e] * t1[e];
#pragma unroll
        for (int k = 1; k < 16; ++k) { up8(hz[k - 1], t0);
#pragma unroll
            for (int e = 0; e < 8; ++e) s[e] += (k < W) ? t0[e] : 0.f; }
    }
#pragma nounroll
    for (int hb4 = 0; hb4 < 16; hb4 += 4) {
        u32x4 rb[4], rc[4], rx[4], rz[4], ro[4];
#pragma unroll
        for (int i = 0; i < 4; ++i) { const int p = p0 + hb4 + i; const bf16* r = urow(u, um, b, p);
            rb[i] = *(const u32x4*)(r + ch); rc[i] = *(const u32x4*)(r + 256 + ch); rx[i] = *(const u32x4*)(r + 512 + ch); rz[i] = *(const u32x4*)(r + 768 + ch);
            ro[i] = *(const u32x4*)(urow(u, um, b, p - W + 1) + 768 + ch); }
        asm volatile("" ::: "memory");
#pragma unroll
        for (int i = 0; i < 4; ++i) { const int p = p0 + hb4 + i; float cb[8], y[8]; bf16* orow = mix + ((size_t)b * SEQ + (p - NMETA)) * D;
            up8(rb[i], cb); up8(rc[i], t0); up8(rx[i], t1);
#pragma unroll
            for (int e = 0; e < 8; ++e) { const float g0 = t0[e] * t1[e]; y[e] = cb[e] * (w0[e] * g2[e] + w1[e] * g1[e] + w2[e] * g0); g2[e] = g1[e]; g1[e] = g0; }
            st8(orow + ch, y);
            up8(rz[i], t0); up8(ro[i], t1);
#pragma unroll
            for (int e = 0; e < 8; ++e) { s[e] += t0[e]; y[e] = s[e] * invW - t0[e]; s[e] -= t1[e]; }
            st8(orow + 256 + ch, y); }
    }
}
__device__ __forceinline__ void mix_convpool_meta(const Args& a, unsigned char* ws, int l, int tid) {
    const bf16* um = (const bf16*)(ws + WS_META + MB_UM); bf16* mixm = (bf16*)(ws + WS_META + MB_MIXM);
    if (tid < 256) { const int c = tid; const float* wc = a.w_conv + (size_t)l * 3 * 256 + c; const float w0 = wc[0], w1 = wc[256], w2 = wc[512];
        unsigned short rb[16], rc[16], rx[16];
#pragma unroll
        for (int p = 0; p < NMETA; ++p) { const bf16* r = um + p * UW; rb[p] = r[c]; rc[p] = r[256 + c]; rx[p] = r[512 + c]; }
        float g2 = 0.f, g1 = 0.f;
#pragma unroll
        for (int p = 0; p < NMETA; ++p) { const float g0 = bf2f(rc[p]) * bf2f(rx[p]); const float y = bf2f(rb[p]) * (w0 * g2 + w1 * g1 + w2 * g0); g2 = g1; g1 = g0;
            mixm[p * D + c] = (bf16)(pk2(y, 0.f) & 0xffffu); } }
    else { const int c = tid - 256; const int W = 2 << (c >> 6);
        float z[16];
#pragma unroll
        for (int p = 0; p < NMETA; ++p) z[p] = bf2f(um[p * UW + 768 + c]);
#pragma unroll
        for (int p = 0; p < NMETA; ++p) { const int cnt = (p + 1 < W) ? p + 1 : W; float s = 0.f;
#pragma unroll
            for (int k = 0; k <= p; ++k) s += (k < W) ? z[p - k] : 0.f;
            const float y = s / (float)cnt - z[p]; mixm[p * D + 256 + c] = (bf16)(pk2(y, 0.f) & 0xffffu); } }
}

constexpr int AT_PITCH = 144, AT_TILE = 64 * AT_PITCH, AT_NT = 7, AT_KOFF = 0, AT_VOFF = AT_NT * AT_TILE;
struct AttnState { f32x16 o0, o1; float carry; };
__device__ __forceinline__ void attn_tile_scores(AttnState& st, u32x4 (&pw)[4], const bf16x8 (&qf)[4], const bf16x8 (&kf)[2][4], int kv0, int P0, int pq, int hi) {
    f32x16 s0 = {}, s1 = {};
#pragma unroll
    for (int d0 = 0; d0 < 4; ++d0) { s0 = __builtin_amdgcn_mfma_f32_32x32x16_bf16(kf[0][d0], qf[d0], s0, 0, 0, 0); s1 = __builtin_amdgcn_mfma_f32_32x32x16_bf16(kf[1][d0], qf[d0], s1, 0, 0, 0); }
    const int kb = kv0 + 32 * hi;
    if (kv0 + 64 > P0) { const int lim = pq - kb - 1;
#pragma unroll
        for (int r = 0; r < 16; ++r) { const int m0 = lim - r, m1 = lim - 16 - r;
            s0[r] = __builtin_fmaf((float)(m0 < 0 ? m0 : 0), 1e30f, s0[r]); s1[r] = __builtin_fmaf((float)(m1 < 0 ? m1 : 0), 1e30f, s1[r]); } }
    f32x16 k0v, k1v; float p0 = 1.f, p1 = 1.f, p2 = 1.f, p3 = 1.f;
#pragma unroll
    for (int r = 0; r < 16; ++r) { k0v[r] = __builtin_amdgcn_rcpf(1.0f + __builtin_amdgcn_exp2f(s0[r])); k1v[r] = __builtin_amdgcn_rcpf(1.0f + __builtin_amdgcn_exp2f(s1[r])); }
#pragma unroll
    for (int r = 0; r < 16; r += 2) { p0 *= k0v[r]; p1 *= k0v[r + 1]; p2 *= k1v[r]; p3 *= k1v[r + 1]; }
    const float tot = (p0 * p1) * (p2 * p3);
    const float oth = __shfl_xor(tot, 32);
    float run = hi ? st.carry : st.carry * oth;
    st.carry = st.carry * (tot * oth);
#pragma unroll
    for (int r = 15; r >= 0; --r) { s1[r] = (1.0f - k1v[r]) * run; run *= k1v[r]; }
#pragma unroll
    for (int r = 15; r >= 0; --r) { s0[r] = (1.0f - k0v[r]) * run; run *= k0v[r]; }
    pw[0] = (u32x4){pk2(s0[0], s0[1]), pk2(s0[2], s0[3]), pk2(s0[4], s0[5]), pk2(s0[6], s0[7])};
    pw[1] = (u32x4){pk2(s0[8], s0[9]), pk2(s0[10], s0[11]), pk2(s0[12], s0[13]), pk2(s0[14], s0[15])};
    pw[2] = (u32x4){pk2(s1[0], s1[1]), pk2(s1[2], s1[3]), pk2(s1[4], s1[5]), pk2(s1[6], s1[7])};
    pw[3] = (u32x4){pk2(s1[8], s1[9]), pk2(s1[10], s1[11]), pk2(s1[12], s1[13]), pk2(s1[14], s1[15])};
}
__device__ __forceinline__ bool attn_tile_pv(AttnState& st, const u32x4 (&pw)[4], const bf16x8 (&vf)[2][4]) {
#pragma unroll
    for (int c = 0; c < 4; ++c) { const bf16x8 pf = __builtin_bit_cast(bf16x8, pw[c]);
        st.o0 = __builtin_amdgcn_mfma_f32_32x32x16_bf16(vf[0][c], pf, st.o0, 0, 0, 0); st.o1 = __builtin_amdgcn_mfma_f32_32x32x16_bf16(vf[1][c], pf, st.o1, 0, 0, 0); }
    return __all(st.carry < 1.1754944e-38f) != 0;
}
__device__ __forceinline__ void attn_stage_load(u32x4 (&kx)[AT_NT], u32x4 (&vx)[AT_NT], const bf16* __restrict__ u, const bf16* __restrict__ um, const bf16* __restrict__ vT, const bf16* __restrict__ vTm,
                                                int b, int h, int Tlo, int tid) {
    const int rr = tid >> 3, ch = tid & 7;
#pragma unroll
    for (int s = 0; s < AT_NT; ++s) {
        int pk = (Tlo + s) * 64 + rr; pk = pk < LPOS ? pk : LPOS - 1;
        kx[s] = *(const u32x4*)(urow(u, um, b, pk) + 1536 + h * 64 + ch * 8);
        int pv = (Tlo + s) * 64 + 8 * ch; pv = pv < LPOS - 8 ? pv : LPOS - 8;
        const int dr = h * 64 + rr;
        vx[s] = *(const u32x4*)(pv < NMETA ? vTm + dr * 16 + pv : vT + (size_t)dr * MT + (size_t)b * SEQ + (pv - NMETA)); }
}
__device__ __forceinline__ void attn_stage_store(LAS unsigned char* lds, const u32x4 (&kx)[AT_NT], const u32x4 (&vx)[AT_NT], int tid) {
    const int rr = tid >> 3, ch = tid & 7;
    const int krow = 32 * ((rr >> 4) & 1) + (rr & 3) + 8 * ((rr & 15) >> 2) + 4 * (rr >> 5);
#pragma unroll
    for (int s = 0; s < AT_NT; ++s) {
        *(LAS u32x4*)(lds + AT_KOFF + s * AT_TILE + krow * AT_PITCH + ch * 16) = kx[s];
        *(LAS u32x4*)(lds + AT_VOFF + s * AT_TILE + rr * AT_PITCH + ch * 16) = vx[s]; }
}
__device__ __forceinline__ void sb_attn_wave(LAS unsigned char* lds, int Tlo, const bf16* __restrict__ u, const bf16* __restrict__ um, const bf16* __restrict__ vT, const bf16* __restrict__ vTm,
                                             int b, int h, int P0, const bf16x8 (&qf)[4], bf16* orow  , int lane) {
    const int r32 = lane & 31, hi = lane >> 5;
    const int pq = P0 + r32;
    AttnState st; st.o0 = (f32x16){}; st.o1 = (f32x16){}; st.carry = 1.f;
    bool done = false;
    int t = (P0 + 30) >> 6;
    const LAS unsigned char* kbase = lds + AT_KOFF + r32 * AT_PITCH + hi * 16;
    const LAS unsigned char* vbase = lds + AT_VOFF + r32 * AT_PITCH + hi * 64;
    const int key0 = 32 * ((r32 >> 2) & 1) + (r32 & 3) + 4 * (r32 >> 3);
#pragma nounroll
    for (; t >= Tlo && !done; --t) {
        const int so = (t - Tlo) * AT_TILE;
        bf16x8 kf[2][4], vf[2][4]; u32x4 pw[4];
#pragma unroll
        for (int hf = 0; hf < 2; ++hf)
#pragma unroll
            for (int d0 = 0; d0 < 4; ++d0) kf[hf][d0] = *(const LAS bf16x8*)(kbase + so + hf * 32 * AT_PITCH + d0 * 32);
        attn_tile_scores(st, pw, qf, kf, t * 64, P0, pq, hi);
        __builtin_amdgcn_sched_barrier(0);
#pragma unroll
        for (int dh = 0; dh < 2; ++dh)
#pragma unroll
            for (int c = 0; c < 4; ++c) vf[dh][c] = *(const LAS bf16x8*)(vbase + so + dh * 32 * AT_PITCH + c * 16);
        done = attn_tile_pv(st, pw, vf);
    }
#pragma nounroll
    for (; t >= 0 && !done; --t) {
        const int kv0 = t * 64;
        bf16x8 kf[2][4], vf[2][4]; u32x4 pw[4];
#pragma unroll
        for (int hf = 0; hf < 2; ++hf) { int pk = kv0 + key0 + 16 * hf; pk = pk < LPOS ? pk : LPOS - 1; const bf16* kr = urow(u, um, b, pk) + 1536 + h * 64 + 8 * hi;
#pragma unroll
            for (int d0 = 0; d0 < 4; ++d0) kf[hf][d0] = *(const bf16x8*)(kr + 16 * d0); }
#pragma unroll
        for (int c = 0; c < 4; ++c) { int pv = kv0 + 32 * hi + 8 * c; pv = pv < LPOS - 8 ? pv : LPOS - 8;
#pragma unroll
            for (int dh = 0; dh < 2; ++dh) { const int dr = h * 64 + dh * 32 + r32;
                const bf16* vp = pv < NMETA ? vTm + dr * 16 + pv : vT + (size_t)dr * MT + (size_t)b * SEQ + (pv - NMETA);
                vf[dh][c] = *(const bf16x8*)vp; } }
        attn_tile_scores(st, pw, qf, kf, kv0, P0, pq, hi);
        done = attn_tile_pv(st, pw, vf);
    }
    if (orow) { bf16* op = orow + h * 64 + 4 * hi;
#pragma unroll
        for (int g = 0; g < 4; ++g) { u32x2 w0, w1; w0.x = pk2(st.o0[4 * g], st.o0[4 * g + 1]); w0.y = pk2(st.o0[4 * g + 2], st.o0[4 * g + 3]); w1.x = pk2(st.o1[4 * g], st.o1[4 * g + 1]); w1.y = pk2(st.o1[4 * g + 2], st.o1[4 * g + 3]);
            *(u32x2*)(op + 8 * g) = w0; *(u32x2*)(op + 32 + 8 * g) = w1; } }
}

#define XB_TMO      128
#define XB_XCNT(j)  (256  + 64 * (j))
#define XB_XSUB(j)  (1280 + 64 * (j))
#define XB_XGEN(j)  (2304 + 64 * (j))
#define XB_TOP      3328
#define XB_TOPGEN   3392
#define XCD_BAR_WORDS 3456
#define XB_SPIN_CAP (1u << 18)
__device__ __forceinline__ unsigned xb_ld(unsigned* p)              { return __hip_atomic_load(p, __ATOMIC_RELAXED, __HIP_MEMORY_SCOPE_AGENT); }
__device__ __forceinline__ unsigned xb_add(unsigned* p, unsigned v) { return __hip_atomic_fetch_add(p, v, __ATOMIC_RELAXED, __HIP_MEMORY_SCOPE_AGENT); }
__device__ __forceinline__ unsigned xb_xcc_id() { return (unsigned)__builtin_amdgcn_s_getreg((3 << 11) | 20) & 0xFu; }
#define XB_SPIN(cond, bar) do { unsigned _sp = 0; while (cond) { __builtin_amdgcn_s_sleep(1); \
    if ((++_sp & 255u) == 0u) { if (xb_ld(&(bar)[XB_TMO])) break; if (_sp > XB_SPIN_CAP) { atomicAdd(&(bar)[XB_TMO], 1u); break; } } } } while (0)
struct XcdBarrier { unsigned* bar; unsigned x; volatile LAS unsigned* st; };
__device__ __forceinline__ XcdBarrier xcd_barrier_post(unsigned* bar, volatile LAS unsigned* st, bool leader) {
    XcdBarrier b; b.bar = bar; b.x = xb_xcc_id(); b.st = st;
    if (leader) (void)xb_add(&bar[XB_XCNT(b.x)], 1u);
    return b;
}
__device__ __forceinline__ void xcd_barrier_complete(unsigned* bar, unsigned x, unsigned& nloc, unsigned& nx) {
    const unsigned G = gridDim.x * gridDim.y * gridDim.z;
    unsigned sum, cnt, mine, sp = 0u;
    for (;;) {
        sum = 0u; cnt = 0u; mine = 0u;
#pragma unroll
        for (unsigned j = 0; j < 16; ++j) { const unsigned c = xb_ld(&bar[XB_XCNT(j)]); sum += c; cnt += (c > 0u) ? 1u : 0u; mine = (j == x) ? c : mine; }
        if (sum == G) break;
        __builtin_amdgcn_s_sleep(1);
        if ((++sp & 255u) == 0u) { if (xb_ld(&bar[XB_TMO])) break; if (sp > XB_SPIN_CAP) { atomicAdd(&bar[XB_TMO], 1u); break; } }
    }
    nloc = mine > 0u ? mine : 1u; nx = cnt > 0u ? cnt : 1u;
}
__device__ __forceinline__ void xcd_barrier(const XcdBarrier& b, bool leader  ) {
    asm volatile("s_waitcnt vmcnt(0)" ::: "memory");
    __syncthreads();
    if (leader) {
        unsigned* bar = b.bar;
        __builtin_amdgcn_s_waitcnt(0);
        unsigned nloc = b.st[0], nx = b.st[1];
        if (nloc == 0u) { xcd_barrier_complete(bar, b.x, nloc, nx); b.st[0] = nloc; b.st[1] = nx; }
        const unsigned old = xb_add(&bar[XB_XSUB(b.x)], 1u);
        const unsigned gen = old / nloc;
        if (old + 1u == (gen + 1u) * nloc) {
            __builtin_amdgcn_fence(__ATOMIC_RELEASE, "agent");
            asm volatile("s_waitcnt vmcnt(0)" ::: "memory");
            const unsigned og = xb_add(&bar[XB_TOP], 1u);
            const unsigned tg = og / nx;
            if (og + 1u == (tg + 1u) * nx) xb_add(&bar[XB_TOPGEN], 1u);
            else XB_SPIN(xb_ld(&bar[XB_TOPGEN]) == tg, bar);
            __builtin_amdgcn_fence(__ATOMIC_ACQUIRE, "agent");
            xb_add(&bar[XB_XGEN(b.x)], 1u);
            asm volatile("s_waitcnt vmcnt(0)" ::: "memory");
        } else {
            XB_SPIN(xb_ld(&bar[XB_XGEN(b.x)]) == gen, bar);
            __builtin_amdgcn_fence(__ATOMIC_ACQUIRE, "agent");
            asm volatile("s_waitcnt vmcnt(0)" ::: "memory");
        }
    }
    __syncthreads();
}

__global__ void __launch_bounds__(NTHREADS, 2) trunk_fwd(Args a) {
    extern __shared__ __attribute__((aligned(16))) unsigned char lds_raw[];
    cg::grid_group grid = cg::this_grid();
    LAS unsigned char* lds = (LAS unsigned char*)lds_raw;
    LAS float* rs = (LAS float*)(lds + LDS_RS);
    const int G = gridDim.x, w = blockIdx.x, NGW = G * NWAVES;
    if (a.ws == nullptr) grid.sync();
    const int wave_id = __builtin_amdgcn_readfirstlane((int)threadIdx.x >> 6);
#define MY_LANE() ((int)__builtin_amdgcn_mbcnt_hi(~0u, __builtin_amdgcn_mbcnt_lo(~0u, 0u)))
#define MY_TID() (wave_id * 64 + MY_LANE())
#define XBAR() xcd_barrier(xbar, wave_id == 0 && MY_LANE() == 0)
    volatile LAS unsigned* bst = (volatile LAS unsigned*)(lds + LDS_RS + 1024);
    if (MY_TID() < 4) bst[MY_TID()] = 0u;
    __syncthreads();
    const XcdBarrier xbar = xcd_barrier_post((unsigned*)a.ws + CW_BAR, bst, wave_id == 0 && MY_LANE() == 0);
#define WSP(T, off) ((T*)(ws + (off)))
#define PHASE_PTRS() unsigned long long wsi_ = (unsigned long long)a.ws; int tid = MY_TID(); asm volatile("" : "+s"(wsi_), "+v"(tid)); \
    unsigned char* ws = (unsigned char*)(__attribute__((address_space(1))) unsigned char*)wsi_; (void)ws;     \
    const int lane = tid & 63, wave = __builtin_amdgcn_readfirstlane(tid >> 6), gw = w * NWAVES + wave; (void)lane; (void)gw
#define LOAD_RSTD() do { if (tid < 256) { const f32x4* p = (const f32x4*)(WSP(float, WS_SSQ) + ((size_t)w * 256 + tid) * 16); float s = 0.f; \
        _Pragma("unroll") for (int j_ = 0; j_ < 4; ++j_) { const f32x4 v = p[j_]; s += (v[0] + v[1]) + (v[2] + v[3]); } \
        rs[tid] = 1.0f / sqrtf(s * (1.0f / D) + EPS); } __syncthreads(); } while (0)

#define BUILD_RSTD_TABLE(S_, nunits) do { LAS float* rt_ = (LAS float*)(lds + 131072); const float* sq_ = WSP(const float, WS_SSQ); \
        _Pragma("unroll 4") for (int i_ = 0; i_ < (nunits); i_ += 2) { pg8::Unit u_; (S_).next(i_ + (tid >> 8), u_); const f32x4* p_ = (const f32x4*)(sq_ + ((size_t)u_.pm * 256 + (tid & 255)) * 16); float s_ = 0.f; \
            _Pragma("unroll") for (int j_ = 0; j_ < 4; ++j_) { const f32x4 v_ = p_[j_]; s_ += (v_[0] + v_[1]) + (v_[2] + v_[3]); } \
            rt_[(i_ + (tid >> 8)) * 256 + (tid & 255)] = 1.0f / sqrtf(s_ * (1.0f / D) + EPS); } __syncthreads(); } while (0)
    { PHASE_PTRS(); prologue(a, lds, w, G, wave, lane); }
    XBAR();

#pragma nounroll
    for (int l = 0; l < DEPTH; ++l) {
        {   PHASE_PTRS(); const bf16* Win = WSP(const bf16, WS_W + W_IN) + (size_t)l * (W_LAYER / 2);
            bf16* um = WSP(bf16, WS_META + MB_UM); bf16* vTm = WSP(bf16, WS_META + MB_VTM);
            const float rm = meta_rstd(WSP(const float, WS_META + MB_SSQM), lane);
            meta_gemm(WSP(const bf16, WS_META + MB_HMB), Win, INW, D, w, G, wave, lane, lds, [&](int tile, int fr, int fq, f32x4 acc) {
                const int c0 = tile * 16 + 4 * fq; const f32x4 v = acc * rm;
                if (c0 < UW) { u32x2 o; o.x = pk2(v[0], v[1]); o.y = pk2(v[2], v[3]); *(u32x2*)(um + fr * UW + c0) = o; }
                else {
#pragma unroll
                    for (int e = 0; e < 4; ++e) vTm[(c0 - UW + e) * 16 + fr] = (bf16)(pk2(v[e], 0.f) & 0xffffu); } });
            LOAD_RSTD();
            { pg8::Gemm g{WSP(const bf16, WS_HB), Win, MT, UW, D}; pg8::StaticOrder S; S.init(MT, UW, G, w); BUILD_RSTD_TABLE(S, (MT / 256) * (UW / 256) / 256);
              pg8::EpiRowScale<0> E{WSP(bf16, WS_U), UW, (const LAS float*)(lds + 131072)};
              pg8::gemm_phase<pg8::EpiRowScale<0>, pg8::StaticOrder, true, true>(lds, g, S, E, tid); }
            { pg8::Gemm g{Win + (size_t)UW * D, WSP(const bf16, WS_HB), 512, MT, D}; pg8::OwnTileOrder S{w, 2, 1}; pg8::EpiColScale E{WSP(bf16, WS_VT), (size_t)MT, rs};
              pg8::gemm_phase<pg8::EpiColScale, pg8::OwnTileOrder, true, true>(lds, g, S, E, tid); }
        }
        XBAR();
        {   PHASE_PTRS();
            const int wv = (w & 7) * (G >> 3) + (w >> 3);
            mix_convpool(a, ws, l, wv, tid);
            if (w == G - 1) mix_convpool_meta(a, ws, l, tid);
            const int nit = (w == G - 1) ? 9 : 8;
            const int jb = wv & 7, Thi = 4 * jb + 4, Tl0 = (4 * jb - 2) > 0 ? (4 * jb - 2) : 0;
            u32x4 kx[AT_NT], vx[AT_NT];
            attn_stage_load(kx, vx, WSP(const bf16, WS_U), WSP(const bf16, WS_META + MB_UM), WSP(const bf16, WS_VT), WSP(const bf16, WS_META + MB_VTM), wv >> 3, 0, Tl0, tid);
#pragma nounroll
            for (int it = 0; it < nit; ++it) {
                const int rb = wave < 4 ? wave : 4 + ((wave + 1) & 3);
                int b = wv >> 3, h = it, P0 = NMETA + 256 * jb + 32 * rb, Tlo = Tl0;
                bf16* orow = WSP(bf16, WS_MIX) + ((size_t)b * SEQ + (P0 - NMETA) + (lane & 31)) * D + 512;
                if (it == 8) { b = 0; h = wave; P0 = 0; Tlo = 1; orow = (lane & 31) < NMETA ? WSP(bf16, WS_META + MB_MIXM) + (lane & 31) * D + 512 : nullptr; }
                asm volatile("" : "+s"(b), "+s"(h), "+s"(P0), "+s"(Tlo));
                __syncthreads();
                if (it < 8) attn_stage_store(lds, kx, vx, tid);
                __syncthreads();
                bf16x8 qf[4];
                { const bf16* qr = urow(WSP(const bf16, WS_U), WSP(const bf16, WS_META + MB_UM), b, P0 + (lane & 31)) + 1024 + h * 64 + 8 * (lane >> 5);
#pragma unroll
                  for (int d0 = 0; d0 < 4; ++d0) qf[d0] = *(const bf16x8*)(qr + 16 * d0); }
                attn_stage_load(kx, vx, WSP(const bf16, WS_U), WSP(const bf16, WS_META + MB_UM), WSP(const bf16, WS_VT), WSP(const bf16, WS_META + MB_VTM), wv >> 3, (it + 1 < 8) ? it + 1 : 7, Tl0, tid);
                sb_attn_wave(lds, Tlo, WSP(const bf16, WS_U), WSP(const bf16, WS_META + MB_UM), WSP(const bf16, WS_VT), WSP(const bf16, WS_META + MB_VTM), b, h, P0, qf, orow, lane);
            }
            __syncthreads();
        }
        XBAR();
        {   PHASE_PTRS(); const bf16* Wout = WSP(const bf16, WS_W + W_OUT) + (size_t)l * (W_LAYER / 2);
            float* hm = WSP(float, WS_META + MB_HM); bf16* hmb = WSP(bf16, WS_META + MB_HMB); float* ssqm = WSP(float, WS_META + MB_SSQM);
            meta_gemm(WSP(const bf16, WS_META + MB_MIXM), Wout, D, D, w, G, wave, lane, lds, [&](int tile, int fr, int fq, f32x4 acc) {
                const int c0 = tile * 16 + 4 * fq; f32x4 v = *(f32x4*)(hm + fr * D + c0) + acc; *(f32x4*)(hm + fr * D + c0) = v;
                u32x2 o; o.x = pk2(v[0], v[1]); o.y = pk2(v[2], v[3]); *(u32x2*)(hmb + fr * D + c0) = o;
                float q = (v[0] * v[0] + v[1] * v[1]) + (v[2] * v[2] + v[3] * v[3]); q += __shfl_xor(q, 16); q += __shfl_xor(q, 32); if (fq == 0) ssqm[fr * 64 + tile] = q; });
            pg8::Gemm g{WSP(const bf16, WS_MIX), Wout, MT, D, D}; pg8::StaticOrder S; S.init(MT, D, G, w); pg8::EpiRes E{l == 0 ? a.x : nullptr, nullptr, WSP(bf16, WS_HB), WSP(float, WS_SSQ)};
            pg8::gemm_phase<pg8::EpiRes, pg8::StaticOrder, true, true>(lds, g, S, E, tid);
        }
        XBAR();
        {   PHASE_PTRS(); const bf16* Wup = WSP(const bf16, WS_W + W_UP) + (size_t)l * (W_LAYER / 2);
            bf16* hidm = WSP(bf16, WS_META + MB_HIDM);
            const float rm = meta_rstd(WSP(const float, WS_META + MB_SSQM), lane);
            meta_gemm(WSP(const bf16, WS_META + MB_HMB), Wup, FF, D, w, G, wave, lane, lds, [&](int tile, int fr, int fq, f32x4 acc) {
                const int c0 = tile * 16 + 4 * fq; f32x4 v = acc * rm;
#pragma unroll
                for (int e = 0; e < 4; ++e) { const float t = fmaxf(v[e], 0.f); v[e] = t * t; }
                u32x2 o; o.x = pk2(v[0], v[1]); o.y = pk2(v[2], v[3]); *(u32x2*)(hidm + fr * FF + c0) = o; });
            pg8::Gemm g{WSP(const bf16, WS_HB), Wup, MT, FF, D}; pg8::StaticOrder S; S.init(MT, FF, G, w); BUILD_RSTD_TABLE(S, (MT / 256) * (FF / 256) / 256);
            pg8::EpiRowScale<1> E{WSP(bf16, WS_HID), FF, (const LAS float*)(lds + 131072)};
            pg8::gemm_phase<pg8::EpiRowScale<1>, pg8::StaticOrder, true, true>(lds, g, S, E, tid);
        }
        XBAR();
        {   PHASE_PTRS(); const bf16* Wdn = WSP(const bf16, WS_W + W_DN) + (size_t)l * (W_LAYER / 2);
            float* hm = WSP(float, WS_META + MB_HM); bf16* hmb = WSP(bf16, WS_META + MB_HMB); float* ssqm = WSP(float, WS_META + MB_SSQM);
            meta_gemm(WSP(const bf16, WS_META + MB_HIDM), Wdn, D, FF, w, G, wave, lane, lds, [&](int tile, int fr, int fq, f32x4 acc) {
                const int c0 = tile * 16 + 4 * fq; f32x4 v = *(f32x4*)(hm + fr * D + c0) + acc; *(f32x4*)(hm + fr * D + c0) = v;
                u32x2 o; o.x = pk2(v[0], v[1]); o.y = pk2(v[2], v[3]); *(u32x2*)(hmb + fr * D + c0) = o;
                float q = (v[0] * v[0] + v[1] * v[1]) + (v[2] * v[2] + v[3] * v[3]); q += __shfl_xor(q, 16); q += __shfl_xor(q, 32); if (fq == 0) ssqm[fr * 64 + tile] = q; });
            pg8::Gemm g{WSP(const bf16, WS_HID), Wdn, MT, D, FF}; pg8::StaticOrder S; S.init(MT, D, G, w); pg8::EpiRes E{nullptr, nullptr, WSP(bf16, WS_HB), WSP(float, WS_SSQ)};
            pg8::gemm_phase<pg8::EpiRes, pg8::StaticOrder, true, true>(lds, g, S, E, tid);
        }
        XBAR();
    }
    {   PHASE_PTRS();
        __builtin_amdgcn_fence(__ATOMIC_ACQUIRE, "agent");
        __syncthreads();
        LOAD_RSTD();
        const f32x4* gf = (const f32x4*)a.g_final + lane; f32x4 gv[4];
#pragma unroll
        for (int jj = 0; jj < 4; ++jj) gv[jj] = gf[64 * jj];
        const bf16* hbf = WSP(const bf16, WS_HB);
        for (int i = wave * 4; i < 256; i += NWAVES * 4) { f32x4* orow = (f32x4*)(a.out + ((size_t)w * 256 + i) * D) + lane; const u32x2* hrow = (const u32x2*)(hbf + ((size_t)w * 256 + i) * D) + lane; u32x2 hv[4][4];
#pragma unroll
            for (int r = 0; r < 4; ++r)
#pragma unroll
                for (int jj = 0; jj < 4; ++jj) hv[r][jj] = hrow[r * 256 + 64 * jj];
#pragma unroll
            for (int r = 0; r < 4; ++r) { const float sc = rs[i + r];
#pragma unroll
                for (int jj = 0; jj < 4; ++jj) { const u32x2 t = hv[r][jj];
                    const f32x4 v = {__uint_as_float(t.x << 16), __uint_as_float(t.x & 0xffff0000u), __uint_as_float(t.y << 16), __uint_as_float(t.y & 0xffff0000u)};
                    __builtin_nontemporal_store(v * sc * gv[jj], orow + r * 256 + 64 * jj); } } }
    }
}

extern "C" void kernel_launch(void* const* d_in, const int* in_sizes, int n_in, void* d_out, int out_size, void* d_ws, size_t ws_size, hipStream_t stream) {
    static int grid = 0;
    if (grid == 0) {
        if (n_in != 12 || in_sizes[0] != MT * D || out_size != MT * D || ws_size < WS_END) { fprintf(stderr, "kernel_launch: unexpected shapes (n_in %d, in0 %d, out %d, ws %zu)\n", n_in, n_in > 0 ? in_sizes[0] : -1, out_size, ws_size); grid = -1; return; }
        int dev = 0, cus = 0, per_cu = 0;
        (void)hipGetDevice(&dev); (void)hipDeviceGetAttribute(&cus, hipDeviceAttributeMultiprocessorCount, dev);
        if (hipFuncSetAttribute((const void*)trunk_fwd, hipFuncAttributeMaxDynamicSharedMemorySize, LDS_BYTES) != hipSuccess) { fprintf(stderr, "kernel_launch: hipFuncSetAttribute failed\n"); grid = -1; return; }
        if (hipOccupancyMaxActiveBlocksPerMultiprocessor(&per_cu, (const void*)trunk_fwd, NTHREADS, LDS_BYTES) != hipSuccess || per_cu < 1) { fprintf(stderr, "kernel_launch: occupancy query says %d blocks/CU\n", per_cu); (void)hipGetLastError(); }
        if (cus != 256) fprintf(stderr, "kernel_launch: built for 256 CUs, device has %d\n", cus);
        grid = 256;
    }
    if (grid < 0) return;
    Args a{};
    a.x = (const float*)d_in[0]; a.meta = (const float*)d_in[1]; a.g_mix = (const float*)d_in[2]; a.w_in = (const float*)d_in[3]; a.w_conv = (const float*)d_in[4];
    a.w_pool = (const float*)d_in[5]; a.pool_scale = (const float*)d_in[6]; a.w_out = (const float*)d_in[7]; a.g_mlp = (const float*)d_in[8]; a.w_up = (const float*)d_in[9];
    a.w_down = (const float*)d_in[10]; a.g_final = (const float*)d_in[11]; a.out = (float*)d_out; a.ws = (unsigned char*)d_ws;
    if (hipMemsetAsync((char*)d_ws + WS_CTL, 0, CTL_ZERO_BYTES, stream) != hipSuccess) { fprintf(stderr, "kernel_launch: hipMemsetAsync of the barrier words failed\n"); return; }
    void* args[] = {&a};
    hipError_t e = hipLaunchCooperativeKernel((const void*)trunk_fwd, dim3(grid), dim3(NTHREADS), args, LDS_BYTES, stream);
    if (e != hipSuccess) fprintf(stderr, "kernel_launch: cooperative launch failed: %s\n", hipGetErrorString(e));
}
```

```cpp
#include <hip/hip_runtime.h>
#include <hip/hip_cooperative_groups.h>
#include <cstdio>
#include <cstdint>
namespace cg = cooperative_groups;

namespace pg8 {
#define PG8_LAS __attribute__((address_space(3)))
typedef unsigned short bf16_t;
typedef short bf16x8 __attribute__((ext_vector_type(8)));
typedef float f32x4 __attribute__((ext_vector_type(4)));
typedef unsigned u32x4 __attribute__((ext_vector_type(4)));
constexpr int BM = 256, BK = 64, HALF = 128, HTB = HALF * BK * 2, STAGE_BYTES = 8 * HTB;

__host__ __device__ __forceinline__ int lds_byte(int r, int c) { const int st = (r >> 4) * 2 + (c >> 5), rr = r & 15, cc = c & 31, ob = rr * 64 + cc * 2; return st * 1024 + (ob ^ (((ob >> 9) & 1) << 5)); }
__host__ __device__ __forceinline__ void stage_rc(int b, int& R, int& C) { const int st = b / 1024, sb = b % 1024, swz = sb ^ (((sb >> 9) & 1) << 5); R = (st >> 1) * 16 + swz / 64; C = (st & 1) * 32 + (swz % 64) / 2; }
__host__ __device__ __forceinline__ int perm32(int rho) { const int n = rho >> 4, i = rho & 15; return 8 * (i >> 2) + 4 * n + (i & 3); }

struct Unit { int pm, pn, idx; };
struct Gemm { const bf16_t* A; const bf16_t* Bt; int M, N, K; };

constexpr int NXCD = 8, WGM = 8;
struct StaticOrder {
    int nM, nN, nwg, G, c;
    __device__ __forceinline__ void init(int M, int N, int G_, int c_) { nM = M / BM; nN = N / BM; nwg = nM * nN; G = G_; c = c_; }
    __device__ __forceinline__ bool next(int i, Unit& u) const {
        const int L = i * G + c; if (L >= nwg) return false;
        int wgid = L; { const int q = nwg / NXCD, r = nwg % NXCD, xcd = wgid % NXCD, off = wgid / NXCD; wgid = (xcd < r ? xcd * (q + 1) : r * (q + 1) + (xcd - r) * q) + off; }
        const int nig = WGM * nN, gid = wgid / nig, fm = gid * WGM, gsz = (nM - fm) < WGM ? (nM - fm) : WGM;
        u.pm = fm + ((wgid % nig) % gsz); u.pn = (wgid % nig) / gsz; u.idx = i; return true;
    }
    __device__ __forceinline__ void a_ready(const Unit&) const {}
    __device__ __forceinline__ void done(const Unit&) const {}
};
struct OwnTileOrder {
    int own, n, swap;
    __device__ __forceinline__ bool next(int i, Unit& u) const { if (i >= n) return false; int o = own; asm volatile("" : "+s"(o)); u.pm = swap ? i : o; u.pn = swap ? o : i; u.idx = i; return true; }
    __device__ __forceinline__ void a_ready(const Unit&) const {}
    __device__ __forceinline__ void done(const Unit&) const {}
};

__device__ __forceinline__ unsigned cvt_pk_bf16(float lo, float hi) { unsigned r; asm volatile("v_cvt_pk_bf16_f32 %0, %1, %2" : "=v"(r) : "v"(lo), "v"(hi)); return r; }

template <int ACT> struct EpiRowScale {
    static constexpr bool PERM = true, AFTER_DRAIN = false;
    bf16_t* O; int ldc; const PG8_LAS float* rst;
    __device__ __forceinline__ void operator()(const f32x4 (&acc)[2][2][4][2], const Unit& u, int wr, int wc, int fr, int fq) const {
        asm volatile("" : "+v"(fr), "+v"(fq));
        const int rl0 = wr * 64 + fr, col0 = u.pn * BM + wc * 32 + 8 * fq;
#pragma unroll
        for (int ai = 0; ai < 2; ++ai)
#pragma unroll
            for (int m = 0; m < 4; ++m) { const int rl = rl0 + ai * HALF + m * 16; bf16_t* rowp = O + (size_t)(u.pm * BM + rl) * ldc + col0;
                const float s = rst[u.idx * BM + rl];
#pragma unroll
                for (int bj = 0; bj < 2; ++bj) { f32x4 v0 = acc[ai][bj][m][0] * s, v1 = acc[ai][bj][m][1] * s;
                    if (ACT == 1) {
#pragma unroll
                        for (int e = 0; e < 4; ++e) { const float a = fmaxf(v0[e], 0.f), b = fmaxf(v1[e], 0.f); v0[e] = a * a; v1[e] = b * b; } }
                    u32x4 w; w.x = cvt_pk_bf16(v0[0], v0[1]); w.y = cvt_pk_bf16(v0[2], v0[3]); w.z = cvt_pk_bf16(v1[0], v1[1]); w.w = cvt_pk_bf16(v1[2], v1[3]);
                    __builtin_nontemporal_store(w, (u32x4*)(rowp + bj * HALF)); } }
    }
};
struct EpiColScale {
    static constexpr bool PERM = true, AFTER_DRAIN = false;
    bf16_t* O; size_t ldc; const PG8_LAS float* rs;
    __device__ __forceinline__ void operator()(const f32x4 (&acc)[2][2][4][2], const Unit& u, int wr, int wc, int fr, int fq) const {
        asm volatile("" : "+v"(fr), "+v"(fq));
        const int rl0 = wr * 64 + fr, cl0 = wc * 32 + 8 * fq;
        f32x4 sv[2][2];
#pragma unroll
        for (int bj = 0; bj < 2; ++bj)
#pragma unroll
            for (int n = 0; n < 2; ++n) sv[bj][n] = *(const PG8_LAS f32x4*)(rs + cl0 + bj * HALF + 4 * n);
#pragma unroll
        for (int ai = 0; ai < 2; ++ai)
#pragma unroll
            for (int m = 0; m < 4; ++m) { const int rl = rl0 + ai * HALF + m * 16; bf16_t* rowp = O + (size_t)(u.pm * BM + rl) * ldc + (size_t)u.pn * BM + cl0;
#pragma unroll
                for (int bj = 0; bj < 2; ++bj) { const f32x4 v0 = acc[ai][bj][m][0] * sv[bj][0], v1 = acc[ai][bj][m][1] * sv[bj][1];
                    u32x4 w; w.x = cvt_pk_bf16(v0[0], v0[1]); w.y = cvt_pk_bf16(v0[2], v0[3]); w.z = cvt_pk_bf16(v1[0], v1[1]); w.w = cvt_pk_bf16(v1[2], v1[3]);
                    *(u32x4*)(rowp + bj * HALF) = w; } }
    }
};
struct EpiRes {
    static constexpr bool PERM = true, AFTER_DRAIN = false;
    const float* res32; float* out32; bf16_t* hb; float* ssq;
    __device__ __forceinline__ void finish_half(const f32x4 (&acc)[2][2][4][2], const f32x4 (&r)[4][2][2], const Unit& u, int ai, int rl0, int col0, int wc, int fq) const {
#pragma unroll
        for (int m = 0; m < 4; ++m) { const size_t row = (size_t)(u.pm * BM + rl0 + ai * HALF + m * 16); const size_t off = row * 1024 + col0; float q = 0.f;
#pragma unroll
            for (int bj = 0; bj < 2; ++bj) {
                const f32x4 v0 = acc[ai][bj][m][0] + r[m][bj][0], v1 = acc[ai][bj][m][1] + r[m][bj][1];
                if (out32) { *(f32x4*)(out32 + off + bj * HALF) = v0; *(f32x4*)(out32 + off + bj * HALF + 4) = v1; }
                q += (v0[0] * v0[0] + v0[1] * v0[1]) + (v0[2] * v0[2] + v0[3] * v0[3]) + (v1[0] * v1[0] + v1[1] * v1[1]) + (v1[2] * v1[2] + v1[3] * v1[3]);
                u32x4 w; w.x = cvt_pk_bf16(v0[0], v0[1]); w.y = cvt_pk_bf16(v0[2], v0[3]); w.z = cvt_pk_bf16(v1[0], v1[1]); w.w = cvt_pk_bf16(v1[2], v1[3]);
                *(u32x4*)(hb + off + bj * HALF) = w; }
            q += __shfl_xor(q, 16); q += __shfl_xor(q, 32);
            if (fq == 0) ssq[row * 16 + u.pn * 4 + wc] = q; }
    }
    __device__ __forceinline__ void operator()(const f32x4 (&acc)[2][2][4][2], const Unit& u, int wr, int wc, int fr, int fq) const {
        asm volatile("" : "+v"(fr), "+v"(fq));
        const int rl0 = wr * 64 + fr, col0 = u.pn * BM + wc * 32 + 8 * fq;
        if (res32) {
#pragma unroll
            for (int ai = 0; ai < 2; ++ai) { f32x4 r[4][2][2];
#pragma unroll
                for (int m = 0; m < 4; ++m)
#pragma unroll
                    for (int bj = 0; bj < 2; ++bj) { const size_t off = (size_t)(u.pm * BM + rl0 + ai * HALF + m * 16) * 1024 + col0 + bj * HALF;
                        r[m][bj][0] = *(const f32x4*)(res32 + off); r[m][bj][1] = *(const f32x4*)(res32 + off + 4); }
                finish_half(acc, r, u, ai, rl0, col0, wc, fq); }
        } else {
            u32x4 hv[2][4][2];
#pragma unroll
            for (int ai = 0; ai < 2; ++ai)
#pragma unroll
                for (int m = 0; m < 4; ++m)
#pragma unroll
                    for (int bj = 0; bj < 2; ++bj) hv[ai][m][bj] = *(const u32x4*)(hb + (size_t)(u.pm * BM + rl0 + ai * HALF + m * 16) * 1024 + col0 + bj * HALF);
            asm volatile("" ::: "memory");
#pragma unroll
            for (int ai = 0; ai < 2; ++ai) { f32x4 r[4][2][2];
#pragma unroll
                for (int m = 0; m < 4; ++m)
#pragma unroll
                    for (int bj = 0; bj < 2; ++bj) { const u32x4 t = hv[ai][m][bj];
                        r[m][bj][0] = (f32x4){__uint_as_float(t.x << 16), __uint_as_float(t.x & 0xffff0000u), __uint_as_float(t.y << 16), __uint_as_float(t.y & 0xffff0000u)};
                        r[m][bj][1] = (f32x4){__uint_as_float(t.z << 16), __uint_as_float(t.z & 0xffff0000u), __uint_as_float(t.w << 16), __uint_as_float(t.w & 0xffff0000u)}; }
                finish_half(acc, r, u, ai, rl0, col0, wc, fq); }
        }
    }
};

template <class Epi, class Sched, bool ALIGN_EPI = false, bool SP2 = false>
__device__ __forceinline__ void gemm_phase(PG8_LAS unsigned char* lds, const Gemm g, const Sched& S, const Epi& E, int tid_in) {
    int tid_ = tid_in; asm volatile("" : "+v"(tid_));
    const int tid = tid_, wid = __builtin_amdgcn_readfirstlane(tid >> 6), lane = tid & 63, wr = wid >> 2, wc = wid & 3, fr = lane & 15, fq = lane >> 4;
    const int K = g.K, nt = K / BK;
    unsigned voffA[2], voffB[2];
#pragma unroll
    for (int i = 0; i < 2; ++i) { int R, C; stage_rc(tid * 16 + i * 8192, R, C); const int Rb = Epi::PERM ? ((R & ~31) + perm32(R & 31)) : R;
        voffA[i] = (unsigned)(R * K + C) * 2u; voffB[i] = (unsigned)(Rb * K + C) * 2u; }
    const size_t kstep = (size_t)(BK * 2);
    const size_t hstep = (size_t)HALF * K * 2;
    const size_t tstep = 2 * hstep;
    const unsigned ldsw = (unsigned)wid * 1024u;
    const int aoff = lds_byte(wr * 64 + fr, fq * 8), boff = lds_byte(wc * 32 + fr, fq * 8);
#define PG8_SA(b, h) (((b) * 2 + (h)) * HTB)
#define PG8_SB(b, h) ((4 + (b) * 2 + (h)) * HTB)
#define PG8_STAGE(bufoff, gbase, voff) do { _Pragma("unroll") for (int _i = 0; _i < 2; ++_i) \
        __builtin_amdgcn_global_load_lds((const unsigned*)((const char*)(gbase) + (voff)[_i]), (PG8_LAS unsigned*)(lds + (bufoff) + ldsw + _i * 8192), 16, 0, 0); } while (0)
#define PG8_LDA(dst, b, h) do { _Pragma("unroll") for (int m = 0; m < 4; ++m) _Pragma("unroll") for (int k = 0; k < 2; ++k) dst[m][k] = *(const PG8_LAS bf16x8*)(lds + PG8_SA(b, h) + aoff + m * 2048 + k * 1024); } while (0)
#define PG8_LDB(dst, b, h) do { _Pragma("unroll") for (int n = 0; n < 2; ++n) _Pragma("unroll") for (int k = 0; k < 2; ++k) dst[n][k] = *(const PG8_LAS bf16x8*)(lds + PG8_SB(b, h) + boff + n * 2048 + k * 1024); } while (0)
#define PG8_MMA(ai, bj, At, Bt) do { __builtin_amdgcn_s_setprio(1); _Pragma("unroll") for (int k = 0; k < 2; ++k) _Pragma("unroll") for (int m = 0; m < 4; ++m) _Pragma("unroll") for (int n = 0; n < 2; ++n) \
        acc[ai][bj][m][n] = __builtin_amdgcn_mfma_f32_16x16x32_bf16(Bt[n][k], At[m][k], acc[ai][bj][m][n], 0, 0, 0); __builtin_amdgcn_s_setprio(0); } while (0)
#define PG8_WAIT_V(n) asm volatile("s_waitcnt vmcnt(" #n ")" ::: "memory")
#define PG8_WAIT_L(n) asm volatile("s_waitcnt lgkmcnt(" #n ")" ::: "memory")
#define PG8_BAR __builtin_amdgcn_s_barrier()
#define PG8_SCHED __builtin_amdgcn_sched_barrier(0)
    Unit cur, nxt; int ui = 0;
    if (!S.next(0, cur)) return;
    f32x4 acc[2][2][4][2];
#pragma unroll
    for (int a = 0; a < 2; ++a)
#pragma unroll
        for (int b = 0; b < 2; ++b)
#pragma unroll
            for (int m = 0; m < 4; ++m)
#pragma unroll
                for (int n = 0; n < 2; ++n) acc[a][b][m][n] = (f32x4){0.f, 0.f, 0.f, 0.f};
    bf16x8 At[4][2], B0[2][2], B1[2][2];
    const char* cA = (const char*)g.A + (size_t)cur.pm * tstep; const char* cB = (const char*)g.Bt + (size_t)cur.pn * tstep;
    S.a_ready(cur);
    if constexpr (SP2) {
        PG8_STAGE(PG8_SB(0, 0), cB, voffB); PG8_STAGE(PG8_SB(0, 1), cB + hstep, voffB); PG8_STAGE(PG8_SA(0, 0), cA, voffA); PG8_STAGE(PG8_SA(0, 1), cA + hstep, voffA);
        if (wr == 1) PG8_BAR;
        PG8_WAIT_V(2); PG8_BAR;
        PG8_STAGE(PG8_SB(1, 0), cB + kstep, voffB); PG8_STAGE(PG8_SA(1, 0), cA + kstep, voffA); PG8_STAGE(PG8_SB(1, 1), cB + hstep + kstep, voffB);
        PG8_WAIT_V(6); PG8_BAR;
    } else {
        PG8_STAGE(PG8_SB(0, 0), cB, voffB); PG8_STAGE(PG8_SA(0, 0), cA, voffA); PG8_STAGE(PG8_SB(0, 1), cB + hstep, voffB); PG8_STAGE(PG8_SA(0, 1), cA + hstep, voffA);
        if (wr == 1) PG8_BAR;
        PG8_WAIT_V(4); PG8_BAR;
        PG8_STAGE(PG8_SB(1, 0), cB + kstep, voffB); PG8_STAGE(PG8_SA(1, 0), cA + kstep, voffA); PG8_STAGE(PG8_SB(1, 1), cB + hstep + kstep, voffB);
        PG8_WAIT_V(6); PG8_BAR;
    }
    for (;;) {
        const bool has_next = S.next(ui + 1, nxt);
        const char* nA = has_next ? (const char*)g.A + (size_t)nxt.pm * tstep : cA; const char* nB = has_next ? (const char*)g.Bt + (size_t)nxt.pn * tstep : cB;
        for (int t = 0; t < nt; t += 2) {
            const bool last = (t == nt - 2);
            const char* a1 = cA + (size_t)(t + 1) * kstep;
            const char* a2 = last ? nA : cA + (size_t)(t + 2) * kstep; const char* b2 = last ? nB : cB + (size_t)(t + 2) * kstep;
            const char* a3 = a2 + kstep; const char* b3 = b2 + kstep;
            if (last && has_next) S.a_ready(nxt);
            if constexpr (SP2) {
            PG8_LDB(B0, 0, 0); PG8_LDB(B1, 0, 1); PG8_SCHED; PG8_LDA(At, 0, 0); PG8_STAGE(PG8_SA(1, 1), a1 + hstep, voffA);
            PG8_WAIT_V(8); PG8_WAIT_L(0); PG8_BAR; PG8_MMA(0, 0, At, B0); PG8_MMA(0, 1, At, B1); PG8_BAR; PG8_SCHED;
            PG8_LDA(At, 0, 1); PG8_STAGE(PG8_SB(0, 0), b2, voffB); PG8_STAGE(PG8_SB(0, 1), b2 + hstep, voffB); PG8_STAGE(PG8_SA(0, 0), a2, voffA);
            PG8_WAIT_V(8); PG8_WAIT_L(0); PG8_BAR; PG8_MMA(1, 0, At, B0); PG8_MMA(1, 1, At, B1); PG8_BAR; PG8_SCHED;
            PG8_LDB(B0, 1, 0); PG8_LDB(B1, 1, 1); PG8_SCHED; PG8_LDA(At, 1, 0); PG8_STAGE(PG8_SA(0, 1), a2 + hstep, voffA);
            PG8_WAIT_V(8); PG8_WAIT_L(0); PG8_BAR; PG8_MMA(0, 0, At, B0); PG8_MMA(0, 1, At, B1); PG8_BAR; PG8_SCHED;
            PG8_LDA(At, 1, 1); PG8_STAGE(PG8_SB(1, 0), b3, voffB); PG8_STAGE(PG8_SB(1, 1), b3 + hstep, voffB); PG8_STAGE(PG8_SA(1, 0), a3, voffA);
            PG8_WAIT_V(8); PG8_WAIT_L(0); PG8_BAR; PG8_MMA(1, 0, At, B0); PG8_MMA(1, 1, At, B1); PG8_BAR; PG8_SCHED;
            } else {
            PG8_LDB(B0, 0, 0); PG8_SCHED; PG8_LDA(At, 0, 0); PG8_STAGE(PG8_SA(1, 1), a1 + hstep, voffA);
            PG8_WAIT_L(8); PG8_BAR; PG8_WAIT_L(0); PG8_MMA(0, 0, At, B0); PG8_BAR; PG8_SCHED;
            PG8_LDB(B1, 0, 1); PG8_STAGE(PG8_SB(0, 0), b2, voffB);
            PG8_BAR; PG8_WAIT_L(0); PG8_MMA(0, 1, At, B1); PG8_BAR;
            PG8_LDA(At, 0, 1); PG8_STAGE(PG8_SA(0, 0), a2, voffA);
            PG8_BAR; PG8_WAIT_L(0); PG8_MMA(1, 0, At, B0); PG8_BAR; PG8_SCHED;
            PG8_STAGE(PG8_SB(0, 1), b2 + hstep, voffB);
            PG8_WAIT_V(6); PG8_BAR; PG8_MMA(1, 1, At, B1); PG8_BAR;
            PG8_LDB(B0, 1, 0); PG8_SCHED; PG8_LDA(At, 1, 0); PG8_STAGE(PG8_SA(0, 1), a2 + hstep, voffA);
            PG8_WAIT_L(8); PG8_BAR; PG8_WAIT_L(0); PG8_MMA(0, 0, At, B0); PG8_BAR; PG8_SCHED;
            PG8_LDB(B1, 1, 1); PG8_STAGE(PG8_SB(1, 0), b3, voffB);
            PG8_BAR; PG8_WAIT_L(0); PG8_MMA(0, 1, At, B1); PG8_BAR;
            PG8_LDA(At, 1, 1); PG8_STAGE(PG8_SA(1, 0), a3, voffA);
            PG8_BAR; PG8_WAIT_L(0); PG8_MMA(1, 0, At, B0); PG8_BAR; PG8_SCHED;
            PG8_STAGE(PG8_SB(1, 1), b3 + hstep, voffB);
            PG8_WAIT_V(6); PG8_BAR; PG8_MMA(1, 1, At, B1); PG8_BAR;
            }
        }
        if constexpr (ALIGN_EPI) { if (wr == 0) PG8_BAR; }
        if constexpr (!Epi::AFTER_DRAIN) { E(acc, cur, wr, wc, fr, fq); S.done(cur); }
        if (!has_next) break;
#pragma unroll
        for (int a = 0; a < 2; ++a)
#pragma unroll
            for (int b = 0; b < 2; ++b)
#pragma unroll
                for (int m = 0; m < 4; ++m)
#pragma unroll
                    for (int n = 0; n < 2; ++n) acc[a][b][m][n] = (f32x4){0.f, 0.f, 0.f, 0.f};
        cur = nxt; cA = nA; cB = nB; ++ui;
        if constexpr (ALIGN_EPI) { if (wr == 1) PG8_BAR; }
    }
    PG8_WAIT_V(0);
    if constexpr (!ALIGN_EPI) { if (wr == 0) PG8_BAR; }
    PG8_BAR;
#undef PG8_SA
#undef PG8_SB
#undef PG8_STAGE
#undef PG8_LDA
#undef PG8_LDB
#undef PG8_MMA
#undef PG8_WAIT_V
#undef PG8_WAIT_L
#undef PG8_BAR
#undef PG8_SCHED
}
}

constexpr int NB = 32, SEQ = 2048, D = 1024, NMETA = 16, DEPTH = 2;
constexpr int MT = NB * SEQ;
constexpr int INW = 2560, UW = 2048, FF = 4096;
constexpr int LPOS = NMETA + SEQ;
constexpr float EPS = 1e-6f;
constexpr int NWAVES = 8, NTHREADS = 512;

typedef unsigned short bf16;
typedef short bf16x8 __attribute__((ext_vector_type(8)));
typedef float f32x4 __attribute__((ext_vector_type(4)));
typedef float f32x16 __attribute__((ext_vector_type(16)));
typedef unsigned u32x4 __attribute__((ext_vector_type(4)));
typedef unsigned u32x2 __attribute__((ext_vector_type(2)));
#define LAS __attribute__((address_space(3)))

constexpr size_t MiB = 1u << 20;
constexpr size_t WS_CTL = 0, CTL_ZERO_BYTES = 65536; constexpr int CW_BAR = 1024;
constexpr size_t WS_W = 1 * MiB;
constexpr size_t W_LAYER = 23 * MiB, W_IN = 0, W_OUT = 5 * MiB, W_UP = 7 * MiB, W_DN = 15 * MiB;
constexpr size_t WS_META = 47 * MiB;
constexpr size_t MB_UM = 0, MB_VTM = 64 * 1024, MB_HM = 80 * 1024, MB_HMB = 144 * 1024, MB_MIXM = 176 * 1024, MB_HIDM = 208 * 1024, MB_SSQM = 336 * 1024;
static_assert(WS_W + 2 * W_LAYER == WS_META && 48 * UW * 2 <= 8 * MiB, "the 192 KB in front of um are layer-1 down-proj weights");
constexpr size_t WS_SSQ = 48 * MiB;
constexpr size_t WS_HB = 52 * MiB;
constexpr size_t WS_U = 180 * MiB;
constexpr size_t WS_VT = 436 * MiB;
constexpr size_t WS_MIX = 500 * MiB;
constexpr size_t WS_HID = 180 * MiB;
constexpr size_t WS_END = 692 * MiB;

constexpr int LDS_STAGE = 147456, LDS_RS = LDS_STAGE, LDS_BYTES = LDS_STAGE + 2048;

__device__ __forceinline__ float bf2f(unsigned short h) { return __uint_as_float((unsigned)h << 16); }
__device__ __forceinline__ unsigned pk2(float lo, float hi) { return pg8::cvt_pk_bf16(lo, hi); }
__device__ __forceinline__ float wave_sum(float v) {
#pragma unroll
    for (int o = 1; o < 64; o <<= 1) v += __shfl_xor(v, o);
    return v;
}

struct Args {
    const float *x, *meta, *g_mix, *w_in, *w_conv, *w_pool, *pool_scale, *w_out, *g_mlp, *w_up, *w_down, *g_final;
    float* out; unsigned char* ws;
};

__device__ __forceinline__ void tile_writeout(LAS float* scr, bf16* WT, int K, int row0, int k0, int lane) {
    const int c = lane & 7;
#pragma unroll
    for (int j = 0; j < 4; ++j) { const int n = (lane >> 3) + 8 * j; const LAS float* s = scr + (8 * c) * 33 + n;
        u32x4 o; o.x = pk2(s[0 * 33], s[1 * 33]); o.y = pk2(s[2 * 33], s[3 * 33]); o.z = pk2(s[4 * 33], s[5 * 33]); o.w = pk2(s[6 * 33], s[7 * 33]);
        *(u32x4*)(WT + (size_t)(row0 + n) * K + k0 + 8 * c) = o; }
    asm volatile("s_waitcnt lgkmcnt(0)" ::: "memory");
}
#define GAS __attribute__((address_space(1)))
__device__ __forceinline__ void transpose_item(const float* W_, int K, int N, bf16* WT, const float* gk_, float cs, LAS float* scr, int kb, int nb, int lane) {
    const int k0 = 64 * kb, n0 = 32 * nb; const GAS float* W = (const GAS float*)W_; const GAS float* gk = (const GAS float*)gk_;
    float wv[32];
#pragma unroll
    for (int i = 0; i < 32; ++i) wv[i] = W[(size_t)(k0 + 2 * i + (lane >> 5)) * N + n0 + (lane & 31)];
#pragma unroll
    for (int i = 0; i < 32; ++i) { const int kk = 2 * i + (lane >> 5); const float gv = gk_ ? gk[k0 + kk] : 1.f;
        scr[kk * 33 + (lane & 31)] = wv[i] * gv * cs; }
    asm volatile("s_waitcnt lgkmcnt(0)" ::: "memory");
    tile_writeout(scr, WT, K, n0, k0, lane);
}
__device__ __forceinline__ void poolfold_item(const float* Win_, const float* wp_, const float* scale, const float* gk, bf16* WT, LAS float* scr, int kb, int nb, int lane) {
    const int k0 = 64 * kb, g = nb >> 1, d = (nb & 1) * 32 + (lane & 31), kh = lane >> 5; const GAS float* Win = (const GAS float*)Win_; const GAS float* wp = (const GAS float*)wp_;
#pragma unroll 32
    for (int i = 0; i < 64; ++i) scr[i * 64 + lane] = Win[(size_t)(k0 + i) * INW + 768 + 64 * g + lane];
    const GAS float* wpc = wp + (size_t)g * 4096 + d;
    float wreg[64];
#pragma unroll
    for (int c = 0; c < 64; ++c) wreg[c] = wpc[c * 64];
    asm volatile("s_waitcnt lgkmcnt(0)" ::: "memory");
    float accv[32];
#pragma unroll
    for (int kk = 0; kk < 32; ++kk) accv[kk] = 0.f;
#pragma unroll
    for (int c = 0; c < 64; c += 4) {
        const float w0 = wreg[c], w1 = wreg[c + 1], w2 = wreg[c + 2], w3 = wreg[c + 3];
#pragma unroll
        for (int kk = 0; kk < 32; ++kk) { const f32x4 a = *(const LAS f32x4*)(scr + (2 * kk + kh) * 64 + c); accv[kk] += (a[0] * w0 + a[1] * w1) + (a[2] * w2 + a[3] * w3); }
    }
    const float sc = scale[64 * g + d];
    asm volatile("s_waitcnt lgkmcnt(0)" ::: "memory");
#pragma unroll
    for (int kk = 0; kk < 32; ++kk) { const int k = 2 * kk + kh; scr[k * 33 + (lane & 31)] = accv[kk] * sc * gk[k0 + k]; }
    asm volatile("s_waitcnt lgkmcnt(0)" ::: "memory");
    tile_writeout(scr, WT, D, 768 + 32 * nb, k0, lane);
}

constexpr float QSCALE = 0.125f * 1.4426950408889634f;

__device__ __forceinline__ void prologue(const Args& a, LAS unsigned char* lds, int w, int G, int wave, int lane) {
    LAS float* scr = (LAS float*)(lds + wave * 16384);
    const int gw = w * NWAVES + wave, NGW = G * NWAVES;
    constexpr int I_IN = 16 * 80, I_OUT = 16 * 32, I_UP = 16 * 128, I_DN = 64 * 32, I_L = I_IN + I_OUT + I_UP + I_DN;
    for (int it = gw; it < DEPTH * I_L; it += NGW) {
        const int l = it / I_L; int r = it % I_L;
        unsigned char* wl = a.ws + WS_W + (size_t)l * W_LAYER;
        if (r < I_IN) { const int kb = r / 80, nb = r % 80; const float* Win = a.w_in + (size_t)l * D * INW; const float* gk = a.g_mix + l * D;
            if (nb >= 24 && nb < 32) poolfold_item(Win, a.w_pool + (size_t)l * 4 * 4096, a.pool_scale + l * 256, gk, (bf16*)(wl + W_IN), scr, kb, nb - 24, lane);
            else transpose_item(Win, D, INW, (bf16*)(wl + W_IN), gk, (nb >= 32 && nb < 48) ? QSCALE : 1.f, scr, kb, nb, lane);
            continue; }
        r -= I_IN;
        if (r < I_OUT) { transpose_item(a.w_out + (size_t)l * D * D, D, D, (bf16*)(wl + W_OUT), nullptr, 1.f, scr, r / 32, r % 32, lane); continue; }
        r -= I_OUT;
        if (r < I_UP) { transpose_item(a.w_up + (size_t)l * D * FF, D, FF, (bf16*)(wl + W_UP), a.g_mlp + l * D, 1.f, scr, r / 128, r % 128, lane); continue; }
        r -= I_UP;
        transpose_item(a.w_down + (size_t)l * FF * D, FF, D, (bf16*)(wl + W_DN), nullptr, 1.f, scr, r / 32, r % 32, lane);
    }
    bf16* hb = (bf16*)(a.ws + WS_HB); float* ssq = (float*)(a.ws + WS_SSQ);
    for (int i = wave * 4; i < 256; i += NWAVES * 4) { const size_t row = (size_t)w * 256 + i;
        const f32x4* xr = (const f32x4*)(a.x + row * D) + lane; f32x4 v[4][4]; float sq[4];
#pragma unroll
        for (int r = 0; r < 4; ++r)
#pragma unroll
            for (int j = 0; j < 4; ++j) v[r][j] = __builtin_nontemporal_load(xr + r * 256 + 64 * j);
#pragma unroll
        for (int r = 0; r < 4; ++r) { float s = 0.f;
#pragma unroll
            for (int j = 0; j < 4; ++j) s += (v[r][j][0] * v[r][j][0] + v[r][j][1] * v[r][j][1]) + (v[r][j][2] * v[r][j][2] + v[r][j][3] * v[r][j][3]);
            sq[r] = wave_sum(s); }
#pragma unroll
        for (int r = 0; r < 4; ++r) { u32x2* o8 = (u32x2*)(hb + (row + r) * D) + lane;
#pragma unroll
            for (int j = 0; j < 4; ++j) { u32x2 o; o.x = pk2(v[r][j][0], v[r][j][1]); o.y = pk2(v[r][j][2], v[r][j][3]); o8[64 * j] = o; }
            if (lane < 16) ssq[(row + r) * 16 + lane] = lane == 0 ? sq[r] : 0.f; } }
    if (w == 0) { unsigned char* mb = a.ws + WS_META; float* hm = (float*)(mb + MB_HM); bf16* hmb = (bf16*)(mb + MB_HMB); float* ssqm = (float*)(mb + MB_SSQM);
        for (int row = wave; row < NMETA; row += NWAVES) { const f32x4* xr = (const f32x4*)(a.meta + row * D) + lane; float s = 0.f;
#pragma unroll
            for (int j = 0; j < 4; ++j) { const f32x4 v = xr[64 * j]; s += (v[0] * v[0] + v[1] * v[1]) + (v[2] * v[2] + v[3] * v[3]);
                ((f32x4*)(hm + row * D))[lane + 64 * j] = v; u32x2 o; o.x = pk2(v[0], v[1]); o.y = pk2(v[2], v[3]); ((u32x2*)(hmb + row * D))[lane + 64 * j] = o; }
            s = wave_sum(s); ssqm[row * 64 + lane] = lane == 0 ? s : 0.f; } }
}

template <class F> __device__ __forceinline__ void meta_gemm(const bf16* A, const bf16* Bt, int N, int K, int w, int G, int wave, int lane, LAS unsigned char* lds, F epi) {
    const int fr = lane & 15, fq = lane >> 4, kc = K / 8;
    for (int tile = w; tile < N / 16; tile += G) {
        const bf16x8* ap = (const bf16x8*)(A + (size_t)fr * K + wave * kc + fq * 8); const bf16x8* bp = (const bf16x8*)(Bt + (size_t)(tile * 16 + fr) * K + wave * kc + fq * 8);
        f32x4 acc0 = {0.f, 0.f, 0.f, 0.f}, acc1 = {0.f, 0.f, 0.f, 0.f};
        for (int kk = 0; kk < kc / 32; kk += 4) {
            const bf16x8 a0 = ap[(kk + 0) * 4], a1 = ap[(kk + 1) * 4], a2 = ap[(kk + 2) * 4], a3 = ap[(kk + 3) * 4];
            const bf16x8 b0 = bp[(kk + 0) * 4], b1 = bp[(kk + 1) * 4], b2 = bp[(kk + 2) * 4], b3 = bp[(kk + 3) * 4];
            acc0 = __builtin_amdgcn_mfma_f32_16x16x32_bf16(b0, a0, acc0, 0, 0, 0); acc1 = __builtin_amdgcn_mfma_f32_16x16x32_bf16(b1, a1, acc1, 0, 0, 0);
            acc0 = __builtin_amdgcn_mfma_f32_16x16x32_bf16(b2, a2, acc0, 0, 0, 0); acc1 = __builtin_amdgcn_mfma_f32_16x16x32_bf16(b3, a3, acc1, 0, 0, 0);
        }
        LAS f32x4* red = (LAS f32x4*)lds;
        red[wave * 64 + lane] = acc0 + acc1;
        __syncthreads();
        if (wave == 0) { f32x4 t = red[lane];
#pragma unroll
            for (int j = 1; j < 8; ++j) t += red[j * 64 + lane];
            epi(tile, fr, fq, t); }
        __syncthreads();
    }
}
__device__ __forceinline__ float meta_rstd(const float* ssqm, int lane) {
    const int fr = lane & 15, fq = lane >> 4; const f32x4* p = (const f32x4*)(ssqm + fr * 64 + fq * 16); float s = 0.f;
#pragma unroll
    for (int j = 0; j < 4; ++j) { const f32x4 v = p[j]; s += (v[0] + v[1]) + (v[2] + v[3]); }
    s += __shfl_xor(s, 16); s += __shfl_xor(s, 32);
    return 1.0f / sqrtf(s * (1.0f / D) + EPS);
}

__device__ __forceinline__ const bf16* urow(const bf16* u, const bf16* um, int b, int p) { return p < NMETA ? um + (size_t)p * UW : u + ((size_t)b * SEQ + (p - NMETA)) * UW; }
__device__ __forceinline__ void ld8(const bf16* p, float (&v)[8]) { const u32x4 r = *(const u32x4*)p;
    v[0] = __uint_as_float(r.x << 16); v[1] = __uint_as_float(r.x & 0xffff0000u); v[2] = __uint_as_float(r.y << 16); v[3] = __uint_as_float(r.y & 0xffff0000u);
    v[4] = __uint_as_float(r.z << 16); v[5] = __uint_as_float(r.z & 0xffff0000u); v[6] = __uint_as_float(r.w << 16); v[7] = __uint_as_float(r.w & 0xffff0000u); }
__device__ __forceinline__ void st8(bf16* p, const float (&v)[8]) { u32x4 o; o.x = pk2(v[0], v[1]); o.y = pk2(v[2], v[3]); o.z = pk2(v[4], v[5]); o.w = pk2(v[6], v[7]); *(u32x4*)p = o; }

__device__ __forceinline__ void up8(const u32x4 r, float (&v)[8]) {
    v[0] = __uint_as_float(r.x << 16); v[1] = __uint_as_float(r.x & 0xffff0000u); v[2] = __uint_as_float(r.y << 16); v[3] = __uint_as_float(r.y & 0xffff0000u);
    v[4] = __uint_as_float(r.z << 16); v[5] = __uint_as_float(r.z & 0xffff0000u); v[6] = __uint_as_float(r.w << 16); v[7] = __uint_as_float(r.w & 0xffff0000u); }
__device__ __forceinline__ void mix_convpool(const Args& a, unsigned char* ws, int l, int w, int tid) {
    const bf16* u = (const bf16*)(ws + WS_U); const bf16* um = (const bf16*)(ws + WS_META + MB_UM); bf16* mix = (bf16*)(ws + WS_MIX);
    const int b = w >> 3, j = w & 7, ch = (tid & 31) * 8, rg = tid >> 5, p0 = NMETA + 256 * j + rg * 16;
    const float* wc = a.w_conv + (size_t)l * 3 * 256 + ch; float w0[8], w1[8], w2[8], g2[8], g1[8], s[8], t0[8], t1[8];
    const int W = 2 << (ch >> 6); const float invW = 1.0f / (float)W;
#pragma unroll
    for (int e = 0; e < 8; ++e) { w0[e] = wc[e]; w1[e] = wc[256 + e]; w2[e] = wc[512 + e]; s[e] = 0.f; }
    {
        u32x4 hc[4], hz[15];
        { const bf16* r = urow(u, um, b, p0 - 2); hc[0] = *(const u32x4*)(r + 256 + ch); hc[1] = *(const u32x4*)(r + 512 + ch);
          r = urow(u, um, b, p0 - 1); hc[2] = *(const u32x4*)(r + 256 + ch); hc[3] = *(const u32x4*)(r + 512 + ch); }
#pragma unroll
        for (int k = 1; k < 16; ++k) hz[k - 1] = *(const u32x4*)(urow(u, um, b, p0 - (k < W ? k : 1)) + 768 + ch);
        up8(hc[0], t0); up8(hc[1], t1);
#pragma unroll
        for (int e = 0; e < 8; ++e) g2[e] = t0[e] * t1[e];
        up8(hc[2], t0); up8(hc[3], t1);
#pragma unroll
        for (int e = 0; e < 8; ++e) g1[e] = t0[e] * t1[e];
#pragma unroll
        for (int k = 1; k < 16; ++k) { up8(hz[k - 1], t0);
#pragma unroll
            for (int e = 0; e < 8; ++e) s[e] += (k < W) ? t0[e] : 0.f; }
    }
#pragma nounroll
    for (int hb4 = 0; hb4 < 16; hb4 += 4) {
        u32x4 rb[4], rc[4], rx[4], rz[4], ro[4];
#pragma unroll
        for (int i = 0; i < 4; ++i) { const int p = p0 + hb4 + i; const bf16* r = urow(u, um, b, p);
            rb[i] = *(const u32x4*)(r + ch); rc[i] = *(const u32x4*)(r + 256 + ch); rx[i] = *(const u32x4*)(r + 512 + ch); rz[i] = *(const u32x4*)(r + 768 + ch);
            ro[i] = *(const u32x4*)(urow(u, um, b, p - W + 1) + 768 + ch); }
        asm volatile("" ::: "memory");
#pragma unroll
        for (int i = 0; i < 4; ++i) { const int p = p0 + hb4 + i; float cb[8], y[8]; bf16* orow = mix + ((size_t)b * SEQ + (p - NMETA)) * D;
            up8(rb[i], cb); up8(rc[i], t0); up8(rx[i], t1);
#pragma unroll
            for (int e = 0; e < 8; ++e) { const float g0 = t0[e] * t1[e]; y[e] = cb[e] * (w0[e] * g2[e] + w1[e] * g1[e] + w2[e] * g0); g2[e] = g1[e]; g1[e] = g0; }
            st8(orow + ch, y);
            up8(rz[i], t0); up8(ro[i], t1);
#pragma unroll
            for (int e = 0; e < 8; ++e) { s[e] += t0[e]; y[e] = s[e] * invW - t0[e]; s[e] -= t1[e]; }
            st8(orow + 256 + ch, y); }
    }
}
__device__ __forceinline__ void mix_convpool_meta(const Args& a, unsigned char* ws, int l, int tid) {
    const bf16* um = (const bf16*)(ws + WS_META + MB_UM); bf16* mixm = (bf16*)(ws + WS_META + MB_MIXM);
    if (tid < 256) { const int c = tid; const float* wc = a.w_conv + (size_t)l * 3 * 256 + c; const float w0 = wc[0], w1 = wc[256], w2 = wc[512];
        unsigned short rb[16], rc[16], rx[16];
#pragma unroll
        for (int p = 0; p < NMETA; ++p) { const bf16* r = um + p * UW; rb[p] = r[c]; rc[p] = r[256 + c]; rx[p] = r[512 + c]; }
        float g2 = 0.f, g1 = 0.f;
#pragma unroll
        for (int p = 0; p < NMETA; ++p) { const float g0 = bf2f(rc[p]) * bf2f(rx[p]); const float y = bf2f(rb[p]) * (w0 * g2 + w1 * g1 + w2 * g0); g2 = g1; g1 = g0;
            mixm[p * D + c] = (bf16)(pk2(y, 0.f) & 0xffffu); } }
    else { const int c = tid - 256; const int W = 2 << (c >> 6);
        float z[16];
#pragma unroll
        for (int p = 0; p < NMETA; ++p) z[p] = bf2f(um[p * UW + 768 + c]);
#pragma unroll
        for (int p = 0; p < NMETA; ++p) { const int cnt = (p + 1 < W) ? p + 1 : W; float s = 0.f;
#pragma unroll
            for (int k = 0; k <= p; ++k) s += (k < W) ? z[p - k] : 0.f;
            const float y = s / (float)cnt - z[p]; mixm[p * D + 256 + c] = (bf16)(pk2(y, 0.f) & 0xffffu); } }
}

constexpr int AT_KSHIFT = 48;
constexpr int AT_PITCH = 144, AT_TILE = 64 * AT_PITCH, AT_NT = 7, AT_KOFF = 0, AT_VOFF = AT_NT * AT_TILE;
struct AttnState { f32x16 o0, o1; float carry; };
__device__ __forceinline__ void attn_tile_scores(AttnState& st, u32x4 (&pw)[4], const bf16x8 (&qf)[4], const bf16x8 (&kf)[2][4], int kv0, int P0, int pq, int hi) {
    f32x16 s0 = {}, s1 = {};
#pragma unroll
    for (int d0 = 0; d0 < 4; ++d0) { s0 = __builtin_amdgcn_mfma_f32_32x32x16_bf16(kf[0][d0], qf[d0], s0, 0, 0, 0); s1 = __builtin_amdgcn_mfma_f32_32x32x16_bf16(kf[1][d0], qf[d0], s1, 0, 0, 0); }
    const int kb = kv0 + 32 * hi;
    if (kv0 + 64 > P0 || kv0 < 0) { const int lim = pq - kb - 1;
#pragma unroll
        for (int r = 0; r < 16; ++r) { int m0 = lim - r, m1 = lim - 16 - r; const int l0 = kb + r, l1 = kb + 16 + r;
            m0 = m0 < l0 ? m0 : l0; m1 = m1 < l1 ? m1 : l1;
            s0[r] = __builtin_fmaf((float)(m0 < 0 ? m0 : 0), 1e30f, s0[r]); s1[r] = __builtin_fmaf((float)(m1 < 0 ? m1 : 0), 1e30f, s1[r]); } }
    f32x16 k0v, k1v; float p0 = 1.f, p1 = 1.f, p2 = 1.f, p3 = 1.f;
#pragma unroll
    for (int r = 0; r < 16; ++r) { k0v[r] = __builtin_amdgcn_rcpf(1.0f + __builtin_amdgcn_exp2f(s0[r])); k1v[r] = __builtin_amdgcn_rcpf(1.0f + __builtin_amdgcn_exp2f(s1[r])); }
#pragma unroll
    for (int r = 0; r < 16; r += 2) { p0 *= k0v[r]; p1 *= k0v[r + 1]; p2 *= k1v[r]; p3 *= k1v[r + 1]; }
    const float tot = (p0 * p1) * (p2 * p3);
    const float oth = __shfl_xor(tot, 32);
    float run = hi ? st.carry : st.carry * oth;
    st.carry = st.carry * (tot * oth);
#pragma unroll
    for (int r = 15; r >= 0; --r) { s1[r] = (1.0f - k1v[r]) * run; run *= k1v[r]; }
#pragma unroll
    for (int r = 15; r >= 0; --r) { s0[r] = (1.0f - k0v[r]) * run; run *= k0v[r]; }
    pw[0] = (u32x4){pk2(s0[0], s0[1]), pk2(s0[2], s0[3]), pk2(s0[4], s0[5]), pk2(s0[6], s0[7])};
    pw[1] = (u32x4){pk2(s0[8], s0[9]), pk2(s0[10], s0[11]), pk2(s0[12], s0[13]), pk2(s0[14], s0[15])};
    pw[2] = (u32x4){pk2(s1[0], s1[1]), pk2(s1[2], s1[3]), pk2(s1[4], s1[5]), pk2(s1[6], s1[7])};
    pw[3] = (u32x4){pk2(s1[8], s1[9]), pk2(s1[10], s1[11]), pk2(s1[12], s1[13]), pk2(s1[14], s1[15])};
}
__device__ __forceinline__ bool attn_tile_pv(AttnState& st, const u32x4 (&pw)[4], const bf16x8 (&vf)[2][4]) {
#pragma unroll
    for (int c = 0; c < 4; ++c) { const bf16x8 pf = __builtin_bit_cast(bf16x8, pw[c]);
        st.o0 = __builtin_amdgcn_mfma_f32_32x32x16_bf16(vf[0][c], pf, st.o0, 0, 0, 0); st.o1 = __builtin_amdgcn_mfma_f32_32x32x16_bf16(vf[1][c], pf, st.o1, 0, 0, 0); }
    return __all(st.carry < 1.1754944e-38f) != 0;
}
__device__ __forceinline__ void attn_stage_load(u32x4 (&kx)[AT_NT], u32x4 (&vx)[AT_NT], const bf16* __restrict__ u, const bf16* __restrict__ um, const bf16* __restrict__ vT, const bf16* __restrict__ vTm,
                                                int b, int h, int Tlo, int tid) {
    const int rr = tid >> 3, ch = tid & 7;
#pragma unroll
    for (int s = 0; s < AT_NT; ++s) {
        int pk = (Tlo + s) * 64 - AT_KSHIFT + rr; pk = pk < LPOS ? pk : LPOS - 1;
        kx[s] = *(const u32x4*)(urow(u, um, b, pk) + 1536 + h * 64 + ch * 8);
        int pv = (Tlo + s) * 64 - AT_KSHIFT + 8 * ch; pv = pv < LPOS - 8 ? pv : LPOS - 8;
        const int dr = h * 64 + rr;
        vx[s] = *(const u32x4*)(pv < NMETA ? vTm + dr * 16 + pv : vT + (size_t)dr * MT + (size_t)b * SEQ + (pv - NMETA)); }
}
__device__ __forceinline__ void attn_stage_store(LAS unsigned char* lds, const u32x4 (&kx)[AT_NT], const u32x4 (&vx)[AT_NT], int tid) {
    const int rr = tid >> 3, ch = tid & 7;
    const int krow = 32 * ((rr >> 4) & 1) + (rr & 3) + 8 * ((rr & 15) >> 2) + 4 * (rr >> 5);
#pragma unroll
    for (int s = 0; s < AT_NT; ++s) {
        *(LAS u32x4*)(lds + AT_KOFF + s * AT_TILE + krow * AT_PITCH + ch * 16) = kx[s];
        *(LAS u32x4*)(lds + AT_VOFF + s * AT_TILE + rr * AT_PITCH + ch * 16) = vx[s]; }
}
__device__ __forceinline__ void sb_attn_wave(LAS unsigned char* lds, int Tlo, const bf16* __restrict__ u, const bf16* __restrict__ um, const bf16* __restrict__ vT, const bf16* __restrict__ vTm,
                                             int b, int h, int P0, const bf16x8 (&qf)[4], bf16* obase  , int nrows  , int lane) {
    const int r32 = lane & 31, hi = lane >> 5;
    const int pq = P0 + r32;
    AttnState st; st.o0 = (f32x16){}; st.o1 = (f32x16){}; st.carry = 1.f;
    bool done = false;
    int t = (P0 + 30 + AT_KSHIFT) >> 6;
    const LAS unsigned char* kbase = lds + AT_KOFF + r32 * AT_PITCH + hi * 16;
    const LAS unsigned char* vbase = lds + AT_VOFF + r32 * AT_PITCH + hi * 64;
    const int key0 = 32 * ((r32 >> 2) & 1) + (r32 & 3) + 4 * (r32 >> 3);
#pragma nounroll
    for (; t >= Tlo && !done; --t) {
        const int so = (t - Tlo) * AT_TILE;
        bf16x8 kf[2][4], vf[2][4]; u32x4 pw[4];
#pragma unroll
        for (int hf = 0; hf < 2; ++hf)
#pragma unroll
            for (int d0 = 0; d0 < 4; ++d0) kf[hf][d0] = *(const LAS bf16x8*)(kbase + so + hf * 32 * AT_PITCH + d0 * 32);
        attn_tile_scores(st, pw, qf, kf, t * 64 - AT_KSHIFT, P0, pq, hi);
        __builtin_amdgcn_sched_barrier(0);
#pragma unroll
        for (int dh = 0; dh < 2; ++dh)
#pragma unroll
            for (int c = 0; c < 4; ++c) vf[dh][c] = *(const LAS bf16x8*)(vbase + so + dh * 32 * AT_PITCH + c * 16);
        done = attn_tile_pv(st, pw, vf);
    }
#pragma nounroll
    for (; t >= 0 && !done; --t) {
        const int kv0 = t * 64 - AT_KSHIFT;
        bf16x8 kf[2][4], vf[2][4]; u32x4 pw[4];
#pragma unroll
        for (int hf = 0; hf < 2; ++hf) { int pk = kv0 + key0 + 16 * hf; pk = pk < LPOS ? pk : LPOS - 1; const bf16* kr = urow(u, um, b, pk) + 1536 + h * 64 + 8 * hi;
#pragma unroll
            for (int d0 = 0; d0 < 4; ++d0) kf[hf][d0] = *(const bf16x8*)(kr + 16 * d0); }
#pragma unroll
        for (int c = 0; c < 4; ++c) { int pv = kv0 + 32 * hi + 8 * c; pv = pv < LPOS - 8 ? pv : LPOS - 8;
#pragma unroll
            for (int dh = 0; dh < 2; ++dh) { const int dr = h * 64 + dh * 32 + r32;
                const bf16* vp = pv < NMETA ? vTm + dr * 16 + pv : vT + (size_t)dr * MT + (size_t)b * SEQ + (pv - NMETA);
                vf[dh][c] = *(const bf16x8*)vp; } }
        attn_tile_scores(st, pw, qf, kf, kv0, P0, pq, hi);
        done = attn_tile_pv(st, pw, vf);
    }
    if (r32 < nrows) { bf16* op = obase + (size_t)r32 * D + h * 64 + 4 * hi;
#pragma unroll
        for (int g = 0; g < 4; ++g) { u32x2 w0, w1; w0.x = pk2(st.o0[4 * g], st.o0[4 * g + 1]); w0.y = pk2(st.o0[4 * g + 2], st.o0[4 * g + 3]); w1.x = pk2(st.o1[4 * g], st.o1[4 * g + 1]); w1.y = pk2(st.o1[4 * g + 2], st.o1[4 * g + 3]);
            *(u32x2*)(op + 8 * g) = w0; *(u32x2*)(op + 32 + 8 * g) = w1; } }
}

#define XB_TMO      128
#define XB_XCNT(j)  (256  + 64 * (j))
#define XB_XSUB(j)  (1280 + 64 * (j))
#define XB_XGEN(j)  (2304 + 64 * (j))
#define XB_TOP      3328
#define XB_TOPGEN   3392
#define XCD_BAR_WORDS 3456
#define XB_SPIN_CAP (1u << 18)
__device__ __forceinline__ unsigned xb_ld(unsigned* p)              { return __hip_atomic_load(p, __ATOMIC_RELAXED, __HIP_MEMORY_SCOPE_AGENT); }
__device__ __forceinline__ unsigned xb_add(unsigned* p, unsigned v) { return __hip_atomic_fetch_add(p, v, __ATOMIC_RELAXED, __HIP_MEMORY_SCOPE_AGENT); }
__device__ __forceinline__ unsigned xb_xcc_id() { return (unsigned)__builtin_amdgcn_s_getreg((3 << 11) | 20) & 0xFu; }
#define XB_SPIN(cond, bar) do { unsigned _sp = 0; while (cond) { __builtin_amdgcn_s_sleep(1); \
    if ((++_sp & 255u) == 0u) { if (xb_ld(&(bar)[XB_TMO])) break; if (_sp > XB_SPIN_CAP) { atomicAdd(&(bar)[XB_TMO], 1u); break; } } } } while (0)
struct XcdBarrier { unsigned* bar; unsigned x; volatile LAS unsigned* st; };
__device__ __forceinline__ XcdBarrier xcd_barrier_post(unsigned* bar, volatile LAS unsigned* st, bool leader) {
    XcdBarrier b; b.bar = bar; b.x = xb_xcc_id(); b.st = st;
    if (leader) (void)xb_add(&bar[XB_XCNT(b.x)], 1u);
    return b;
}
__device__ __forceinline__ void xcd_barrier_complete(unsigned* bar, unsigned x, unsigned& nloc, unsigned& nx) {
    const unsigned G = gridDim.x * gridDim.y * gridDim.z;
    unsigned sum, cnt, mine, sp = 0u;
    for (;;) {
        sum = 0u; cnt = 0u; mine = 0u;
#pragma unroll
        for (unsigned j = 0; j < 16; ++j) { const unsigned c = xb_ld(&bar[XB_XCNT(j)]); sum += c; cnt += (c > 0u) ? 1u : 0u; mine = (j == x) ? c : mine; }
        if (sum == G) break;
        __builtin_amdgcn_s_sleep(1);
        if ((++sp & 255u) == 0u) { if (xb_ld(&bar[XB_TMO])) break; if (sp > XB_SPIN_CAP) { atomicAdd(&bar[XB_TMO], 1u); break; } }
    }
    nloc = mine > 0u ? mine : 1u; nx = cnt > 0u ? cnt : 1u;
}
__device__ __forceinline__ void xcd_barrier(const XcdBarrier& b, bool leader  ) {
    asm volatile("s_waitcnt vmcnt(0)" ::: "memory");
    __syncthreads();
    if (leader) {
        unsigned* bar = b.bar;
        __builtin_amdgcn_s_waitcnt(0);
        unsigned nloc = b.st[0], nx = b.st[1];
        if (nloc == 0u) { xcd_barrier_complete(bar, b.x, nloc, nx); b.st[0] = nloc; b.st[1] = nx; }
        const unsigned old = xb_add(&bar[XB_XSUB(b.x)], 1u);
        const unsigned gen = old / nloc;
        if (old + 1u == (gen + 1u) * nloc) {
            __builtin_amdgcn_fence(__ATOMIC_RELEASE, "agent");
            asm volatile("s_waitcnt vmcnt(0)" ::: "memory");
            const unsigned og = xb_add(&bar[XB_TOP], 1u);
            const unsigned tg = og / nx;
            if (og + 1u == (tg + 1u) * nx) xb_add(&bar[XB_TOPGEN], 1u);
            else XB_SPIN(xb_ld(&bar[XB_TOPGEN]) == tg, bar);
            __builtin_amdgcn_fence(__ATOMIC_ACQUIRE, "agent");
            xb_add(&bar[XB_XGEN(b.x)], 1u);
            asm volatile("s_waitcnt vmcnt(0)" ::: "memory");
        } else {
            XB_SPIN(xb_ld(&bar[XB_XGEN(b.x)]) == gen, bar);
            __builtin_amdgcn_fence(__ATOMIC_ACQUIRE, "agent");
            asm volatile("s_waitcnt vmcnt(0)" ::: "memory");
        }
    }
    __syncthreads();
}

__global__ void __launch_bounds__(NTHREADS, 2) trunk_fwd(Args a) {
    extern __shared__ __attribute__((aligned(16))) unsigned char lds_raw[];
    cg::grid_group grid = cg::this_grid();
    LAS unsigned char* lds = (LAS unsigned char*)lds_raw;
    LAS float* rs = (LAS float*)(lds + LDS_RS);
    const int G = gridDim.x, w = blockIdx.x, NGW = G * NWAVES;
    if (a.ws == nullptr) grid.sync();
    const int wave_id = __builtin_amdgcn_readfirstlane((int)threadIdx.x >> 6);
#define MY_LANE() ((int)__builtin_amdgcn_mbcnt_hi(~0u, __builtin_amdgcn_mbcnt_lo(~0u, 0u)))
#define MY_TID() (wave_id * 64 + MY_LANE())
#define XBAR() xcd_barrier(xbar, wave_id == 0 && MY_LANE() == 0)
    volatile LAS unsigned* bst = (volatile LAS unsigned*)(lds + LDS_RS + 1024);
    if (MY_TID() < 4) bst[MY_TID()] = 0u;
    __syncthreads();
    const XcdBarrier xbar = xcd_barrier_post((unsigned*)a.ws + CW_BAR, bst, wave_id == 0 && MY_LANE() == 0);
#define WSP(T, off) ((T*)(ws + (off)))
#define PHASE_PTRS() unsigned long long wsi_ = (unsigned long long)a.ws; int tid = MY_TID(); asm volatile("" : "+s"(wsi_), "+v"(tid)); \
    unsigned char* ws = (unsigned char*)(__attribute__((address_space(1))) unsigned char*)wsi_; (void)ws;     \
    const int lane = tid & 63, wave = __builtin_amdgcn_readfirstlane(tid >> 6), gw = w * NWAVES + wave; (void)lane; (void)gw
#define LOAD_RSTD() do { if (tid < 256) { const f32x4* p = (const f32x4*)(WSP(float, WS_SSQ) + ((size_t)w * 256 + tid) * 16); float s = 0.f; \
        _Pragma("unroll") for (int j_ = 0; j_ < 4; ++j_) { const f32x4 v = p[j_]; s += (v[0] + v[1]) + (v[2] + v[3]); } \
        rs[tid] = 1.0f / sqrtf(s * (1.0f / D) + EPS); } __syncthreads(); } while (0)

#define BUILD_RSTD_TABLE(S_, nunits) do { LAS float* rt_ = (LAS float*)(lds + 131072); const float* sq_ = WSP(const float, WS_SSQ); \
        _Pragma("unroll 4") for (int i_ = 0; i_ < (nunits); i_ += 2) { pg8::Unit u_; (S_).next(i_ + (tid >> 8), u_); const f32x4* p_ = (const f32x4*)(sq_ + ((size_t)u_.pm * 256 + (tid & 255)) * 16); float s_ = 0.f; \
            _Pragma("unroll") for (int j_ = 0; j_ < 4; ++j_) { const f32x4 v_ = p_[j_]; s_ += (v_[0] + v_[1]) + (v_[2] + v_[3]); } \
            rt_[(i_ + (tid >> 8)) * 256 + (tid & 255)] = 1.0f / sqrtf(s_ * (1.0f / D) + EPS); } __syncthreads(); } while (0)
    { PHASE_PTRS(); prologue(a, lds, w, G, wave, lane); }
    XBAR();

#pragma nounroll
    for (int l = 0; l < DEPTH; ++l) {
        {   PHASE_PTRS(); const bf16* Win = WSP(const bf16, WS_W + W_IN) + (size_t)l * (W_LAYER / 2);
            bf16* um = WSP(bf16, WS_META + MB_UM); bf16* vTm = WSP(bf16, WS_META + MB_VTM);
            const float rm = meta_rstd(WSP(const float, WS_META + MB_SSQM), lane);
            meta_gemm(WSP(const bf16, WS_META + MB_HMB), Win, INW, D, w, G, wave, lane, lds, [&](int tile, int fr, int fq, f32x4 acc) {
                const int c0 = tile * 16 + 4 * fq; const f32x4 v = acc * rm;
                if (c0 < UW) { u32x2 o; o.x = pk2(v[0], v[1]); o.y = pk2(v[2], v[3]); *(u32x2*)(um + fr * UW + c0) = o; }
                else {
#pragma unroll
                    for (int e = 0; e < 4; ++e) vTm[(c0 - UW + e) * 16 + fr] = (bf16)(pk2(v[e], 0.f) & 0xffffu); } });
            LOAD_RSTD();
            { pg8::Gemm g{WSP(const bf16, WS_HB), Win, MT, UW, D}; pg8::StaticOrder S; S.init(MT, UW, G, w); BUILD_RSTD_TABLE(S, (MT / 256) * (UW / 256) / 256);
              pg8::EpiRowScale<0> E{WSP(bf16, WS_U), UW, (const LAS float*)(lds + 131072)};
              pg8::gemm_phase<pg8::EpiRowScale<0>, pg8::StaticOrder, true, true>(lds, g, S, E, tid); }
            { pg8::Gemm g{Win + (size_t)UW * D, WSP(const bf16, WS_HB), 512, MT, D}; pg8::OwnTileOrder S{w, 2, 1}; pg8::EpiColScale E{WSP(bf16, WS_VT), (size_t)MT, rs};
              pg8::gemm_phase<pg8::EpiColScale, pg8::OwnTileOrder, true, true>(lds, g, S, E, tid); }
        }
        XBAR();
        {   PHASE_PTRS();
            const int wv = (w & 7) * (G >> 3) + (w >> 3);
            mix_convpool(a, ws, l, wv, tid);
            if (w == G - 1) mix_convpool_meta(a, ws, l, tid);
            const int nit = (w == G - 1) ? 9 : 8;
            const int jb = wv & 7, Thi = 4 * jb + 4, Tl0 = (4 * jb - 2) > 0 ? (4 * jb - 2) : 0;
            u32x4 kx[AT_NT], vx[AT_NT];
            attn_stage_load(kx, vx, WSP(const bf16, WS_U), WSP(const bf16, WS_META + MB_UM), WSP(const bf16, WS_VT), WSP(const bf16, WS_META + MB_VTM), wv >> 3, 0, Tl0, tid);
#pragma nounroll
            for (int it = 0; it < nit; ++it) {
                const int rb = wave < 4 ? wave : 4 + ((wave + 1) & 3);
                int b = wv >> 3, h = it, P0 = NMETA + 256 * jb + 32 * rb, Tlo = Tl0;
                bf16* obase = WSP(bf16, WS_MIX) + ((size_t)b * SEQ + (P0 - NMETA)) * D + 512; int nrows = 32;
                if (it == 8) { b = 0; h = wave; P0 = 0; Tlo = 2; obase = WSP(bf16, WS_META + MB_MIXM) + 512; nrows = NMETA; }
                asm volatile("" : "+s"(b), "+s"(h), "+s"(P0), "+s"(Tlo));
                __syncthreads();
                if (it < 8) attn_stage_store(lds, kx, vx, tid);
                __syncthreads();
                bf16x8 qf[4];
                { const bf16* qr = urow(WSP(const bf16, WS_U), WSP(const bf16, WS_META + MB_UM), b, P0 + (lane & 31)) + 1024 + h * 64 + 8 * (lane >> 5);
#pragma unroll
                  for (int d0 = 0; d0 < 4; ++d0) qf[d0] = *(const bf16x8*)(qr + 16 * d0); }
                attn_stage_load(kx, vx, WSP(const bf16, WS_U), WSP(const bf16, WS_META + MB_UM), WSP(const bf16, WS_VT), WSP(const bf16, WS_META + MB_VTM), wv >> 3, (it + 1 < 8) ? it + 1 : 7, Tl0, tid);
                sb_attn_wave(lds, Tlo, WSP(const bf16, WS_U), WSP(const bf16, WS_META + MB_UM), WSP(const bf16, WS_VT), WSP(const bf16, WS_META + MB_VTM), b, h, P0, qf, obase, nrows, lane);
            }
            __syncthreads();
        }
        XBAR();
        {   PHASE_PTRS(); const bf16* Wout = WSP(const bf16, WS_W + W_OUT) + (size_t)l * (W_LAYER / 2);
            float* hm = WSP(float, WS_META + MB_HM); bf16* hmb = WSP(bf16, WS_META + MB_HMB); float* ssqm = WSP(float, WS_META + MB_SSQM);
            meta_gemm(WSP(const bf16, WS_META + MB_MIXM), Wout, D, D, w, G, wave, lane, lds, [&](int tile, int fr, int fq, f32x4 acc) {
                const int c0 = tile * 16 + 4 * fq; f32x4 v = *(f32x4*)(hm + fr * D + c0) + acc; *(f32x4*)(hm + fr * D + c0) = v;
                u32x2 o; o.x = pk2(v[0], v[1]); o.y = pk2(v[2], v[3]); *(u32x2*)(hmb + fr * D + c0) = o;
                float q = (v[0] * v[0] + v[1] * v[1]) + (v[2] * v[2] + v[3] * v[3]); q += __shfl_xor(q, 16); q += __shfl_xor(q, 32); if (fq == 0) ssqm[fr * 64 + tile] = q; });
            pg8::Gemm g{WSP(const bf16, WS_MIX), Wout, MT, D, D}; pg8::StaticOrder S; S.init(MT, D, G, w); pg8::EpiRes E{l == 0 ? a.x : nullptr, nullptr, WSP(bf16, WS_HB), WSP(float, WS_SSQ)};
            pg8::gemm_phase<pg8::EpiRes, pg8::StaticOrder, true, true>(lds, g, S, E, tid);
        }
        XBAR();
        {   PHASE_PTRS(); const bf16* Wup = WSP(const bf16, WS_W + W_UP) + (size_t)l * (W_LAYER / 2);
            bf16* hidm = WSP(bf16, WS_META + MB_HIDM);
            const float rm = meta_rstd(WSP(const float, WS_META + MB_SSQM), lane);
            meta_gemm(WSP(const bf16, WS_META + MB_HMB), Wup, FF, D, w, G, wave, lane, lds, [&](int tile, int fr, int fq, f32x4 acc) {
                const int c0 = tile * 16 + 4 * fq; f32x4 v = acc * rm;
#pragma unroll
                for (int e = 0; e < 4; ++e) { const float t = fmaxf(v[e], 0.f); v[e] = t * t; }
                u32x2 o; o.x = pk2(v[0], v[1]); o.y = pk2(v[2], v[3]); *(u32x2*)(hidm + fr * FF + c0) = o; });
            pg8::Gemm g{WSP(const bf16, WS_HB), Wup, MT, FF, D}; pg8::StaticOrder S; S.init(MT, FF, G, w); BUILD_RSTD_TABLE(S, (MT / 256) * (FF / 256) / 256);
            pg8::EpiRowScale<1> E{WSP(bf16, WS_HID), FF, (const LAS float*)(lds + 131072)};
            pg8::gemm_phase<pg8::EpiRowScale<1>, pg8::StaticOrder, true, true>(lds, g, S, E, tid);
        }
        XBAR();
        {   PHASE_PTRS(); const bf16* Wdn = WSP(const bf16, WS_W + W_DN) + (size_t)l * (W_LAYER / 2);
            float* hm = WSP(float, WS_META + MB_HM); bf16* hmb = WSP(bf16, WS_META + MB_HMB); float* ssqm = WSP(float, WS_META + MB_SSQM);
            meta_gemm(WSP(const bf16, WS_META + MB_HIDM), Wdn, D, FF, w, G, wave, lane, lds, [&](int tile, int fr, int fq, f32x4 acc) {
                const int c0 = tile * 16 + 4 * fq; f32x4 v = *(f32x4*)(hm + fr * D + c0) + acc; *(f32x4*)(hm + fr * D + c0) = v;
                u32x2 o; o.x = pk2(v[0], v[1]); o.y = pk2(v[2], v[3]); *(u32x2*)(hmb + fr * D + c0) = o;
                float q = (v[0] * v[0] + v[1] * v[1]) + (v[2] * v[2] + v[3] * v[3]); q += __shfl_xor(q, 16); q += __shfl_xor(q, 32); if (fq == 0) ssqm[fr * 64 + tile] = q; });
            pg8::Gemm g{WSP(const bf16, WS_HID), Wdn, MT, D, FF}; pg8::StaticOrder S; S.init(MT, D, G, w); pg8::EpiRes E{nullptr, nullptr, WSP(bf16, WS_HB), WSP(float, WS_SSQ)};
            pg8::gemm_phase<pg8::EpiRes, pg8::StaticOrder, true, true>(lds, g, S, E, tid);
        }
        XBAR();
    }
    {   PHASE_PTRS();
        __builtin_amdgcn_fence(__ATOMIC_ACQUIRE, "agent");
        __syncthreads();
        LOAD_RSTD();
        const f32x4* gf = (const f32x4*)a.g_final + lane; f32x4 gv[4];
#pragma unroll
        for (int jj = 0; jj < 4; ++jj) gv[jj] = gf[64 * jj];
        const bf16* hbf = WSP(const bf16, WS_HB);
        for (int i = wave * 4; i < 256; i += NWAVES * 4) { f32x4* orow = (f32x4*)(a.out + ((size_t)w * 256 + i) * D) + lane; const u32x2* hrow = (const u32x2*)(hbf + ((size_t)w * 256 + i) * D) + lane; u32x2 hv[4][4];
#pragma unroll
            for (int r = 0; r < 4; ++r)
#pragma unroll
                for (int jj = 0; jj < 4; ++jj) hv[r][jj] = hrow[r * 256 + 64 * jj];
#pragma unroll
            for (int r = 0; r < 4; ++r) { const float sc = rs[i + r];
#pragma unroll
                for (int jj = 0; jj < 4; ++jj) { const u32x2 t = hv[r][jj];
                    const f32x4 v = {__uint_as_float(t.x << 16), __uint_as_float(t.x & 0xffff0000u), __uint_as_float(t.y << 16), __uint_as_float(t.y & 0xffff0000u)};
                    __builtin_nontemporal_store(v * sc * gv[jj], orow + r * 256 + 64 * jj); } } }
    }
}

extern "C" void kernel_launch(void* const* d_in, const int* in_sizes, int n_in, void* d_out, int out_size, void* d_ws, size_t ws_size, hipStream_t stream) {
    static int grid = 0;
    if (grid == 0) {
        if (n_in != 12 || in_sizes[0] != MT * D || out_size != MT * D || ws_size < WS_END) { fprintf(stderr, "kernel_launch: unexpected shapes (n_in %d, in0 %d, out %d, ws %zu)\n", n_in, n_in > 0 ? in_sizes[0] : -1, out_size, ws_size); grid = -1; return; }
        int dev = 0, cus = 0, per_cu = 0;
        (void)hipGetDevice(&dev); (void)hipDeviceGetAttribute(&cus, hipDeviceAttributeMultiprocessorCount, dev);
        if (hipFuncSetAttribute((const void*)trunk_fwd, hipFuncAttributeMaxDynamicSharedMemorySize, LDS_BYTES) != hipSuccess) { fprintf(stderr, "kernel_launch: hipFuncSetAttribute failed\n"); grid = -1; return; }
        if (hipOccupancyMaxActiveBlocksPerMultiprocessor(&per_cu, (const void*)trunk_fwd, NTHREADS, LDS_BYTES) != hipSuccess || per_cu < 1) { fprintf(stderr, "kernel_launch: occupancy query says %d blocks/CU\n", per_cu); (void)hipGetLastError(); }
        if (cus != 256) fprintf(stderr, "kernel_launch: built for 256 CUs, device has %d\n", cus);
        grid = 256;
    }
    if (grid < 0) return;
    Args a{};
    a.x = (const float*)d_in[0]; a.meta = (const float*)d_in[1]; a.g_mix = (const float*)d_in[2]; a.w_in = (const float*)d_in[3]; a.w_conv = (const float*)d_in[4];
    a.w_pool = (const float*)d_in[5]; a.pool_scale = (const float*)d_in[6]; a.w_out = (const float*)d_in[7]; a.g_mlp = (const float*)d_in[8]; a.w_up = (const float*)d_in[9];
    a.w_down = (const float*)d_in[10]; a.g_final = (const float*)d_in[11]; a.out = (float*)d_out; a.ws = (unsigned char*)d_ws;
    if (hipMemsetAsync((char*)d_ws + WS_CTL, 0, CTL_ZERO_BYTES, stream) != hipSuccess) { fprintf(stderr, "kernel_launch: hipMemsetAsync of the barrier words failed\n"); return; }
    void* args[] = {&a};
    hipError_t e = hipLaunchCooperativeKernel((const void*)trunk_fwd, dim3(grid), dim3(NTHREADS), args, LDS_BYTES, stream);
    if (e != hipSuccess) fprintf(stderr, "kernel_launch: cooperative launch failed: %s\n", hipGetErrorString(e));
}
```
